# Optimizing an MI355X kernel written in HIP

```python
import math
import jax, jax.numpy as jnp
from jax import lax
import numpy as np

D_MODEL = 2048
BATCH = 2
SEQ = 8192
DEPTH = 1

CHUNK = 64
Q_BLOCK = 128
EPS = 1e-6
NEG_INF = -1e30

MLA_HEADS = 16
MLA_Q_RANK = 768
MLA_KV_RANK = 512
MLA_NOPE = 128
MLA_ROPE = 64
MLA_V = 128
MLA_QK = MLA_NOPE + MLA_ROPE
ROPE_THETA = 10000.0

DIFF_HEADS = 8
DIFF_HEAD_DIM = 128
DIFF_V = 2 * DIFF_HEAD_DIM

N_BRANCH = 2
MLA_MIX = MLA_HEADS * MLA_V
DIFF_MIX = DIFF_HEADS * DIFF_V

D_FF = -(-8 * D_MODEL // (3 * 256)) * 256

IN_SIZES = (MLA_Q_RANK, MLA_KV_RANK, MLA_ROPE,
            DIFF_HEADS * 2 * DIFF_HEAD_DIM, DIFF_HEADS * 2 * DIFF_HEAD_DIM, DIFF_MIX,
            N_BRANCH * D_MODEL)
D_IN = sum(IN_SIZES)

kernel_name = "hybrid_mla_diffattn_gated_block"


def rmsnorm(x, g):
    xf = x.astype(jnp.float32)
    y = xf * lax.rsqrt(jnp.mean(xf * xf, axis=-1, keepdims=True) + EPS)
    return (y * g.astype(jnp.float32)).astype(x.dtype)


def rope_tables(pos, dim):
    inv = ROPE_THETA ** (-jnp.arange(0, dim, 2, dtype=jnp.float32) / dim)
    ang = pos.astype(jnp.float32)[:, None] * inv[None, :]
    return jnp.cos(ang), jnp.sin(ang)


def apply_rope(x, cos, sin):
    half = x.shape[-1] // 2
    xf = x.astype(jnp.float32)
    x1, x2 = xf[..., :half], xf[..., half:]
    c, s = cos[:, None, :], sin[:, None, :]
    return jnp.concatenate([x1 * c - x2 * s, x2 * c + x1 * s], axis=-1).astype(x.dtype)


def to_blocks(a):
    b, s = a.shape[:2]
    return jnp.moveaxis(a.reshape((b, s // Q_BLOCK, Q_BLOCK) + a.shape[2:]), 1, 0)


def from_blocks(a):
    nb, b, q = a.shape[:3]
    return jnp.moveaxis(a, 0, 1).reshape((b, nb * q) + a.shape[3:])


def chunk_allowed(q_pos, k_pos):
    return (k_pos[None, :] // CHUNK) <= (q_pos[:, None] // CHUNK)


def mla_branch(c_q, c_kv, k_pe, q_norm_g, w_uq, kv_norm_g, w_ukv, cos, sin):
    b, s, _ = c_q.shape
    q = (rmsnorm(c_q, q_norm_g) @ w_uq).reshape(b, s, MLA_HEADS, MLA_QK)
    q_nope = q[..., :MLA_NOPE]
    q_rope = apply_rope(q[..., MLA_NOPE:], cos, sin)
    kv = (rmsnorm(c_kv, kv_norm_g) @ w_ukv).reshape(b, s, MLA_HEADS, MLA_NOPE + MLA_V)
    k_nope, v = kv[..., :MLA_NOPE], kv[..., MLA_NOPE:]
    k_rope = apply_rope(k_pe[:, :, None, :], cos, sin)[:, :, 0, :]
    k_pos = jnp.arange(s)
    scale = 1.0 / math.sqrt(MLA_QK)

    def blk(args):
        qn, qr, bi = args
        q_pos = bi * Q_BLOCK + jnp.arange(Q_BLOCK)
        sc = (jnp.einsum('bqhd,bkhd->bhqk', qn, k_nope).astype(jnp.float32)
              + jnp.einsum('bqhr,bkr->bhqk', qr, k_rope).astype(jnp.float32)) * scale
        sc = jnp.where(chunk_allowed(q_pos, k_pos)[None, None], sc, NEG_INF)
        p = jax.nn.softmax(sc, axis=-1).astype(v.dtype)
        return jnp.einsum('bhqk,bkhd->bqhd', p, v)

    nb = s // Q_BLOCK
    o = lax.map(blk, (to_blocks(q_nope), to_blocks(q_rope), jnp.arange(nb)))
    return from_blocks(o).reshape(b, s, MLA_MIX)


def diff_branch(dq, dk, dv, lq1, lk1, lq2, lk2, sub_g, lambda_init, slopes):
    b, s, _ = dq.shape
    q = dq.reshape(b, s, DIFF_HEADS, 2, DIFF_HEAD_DIM)
    k = dk.reshape(b, s, DIFF_HEADS, 2, DIFF_HEAD_DIM)
    v = dv.reshape(b, s, DIFF_HEADS, DIFF_V)
    lam = (jnp.exp(jnp.sum(lq1.astype(jnp.float32) * lk1.astype(jnp.float32)))
           - jnp.exp(jnp.sum(lq2.astype(jnp.float32) * lk2.astype(jnp.float32)))
           + lambda_init)
    k_pos = jnp.arange(s)
    scale = 1.0 / math.sqrt(DIFF_HEAD_DIM)

    def blk(args):
        qb, bi = args
        q_pos = bi * Q_BLOCK + jnp.arange(Q_BLOCK)
        dist = jnp.abs(q_pos[:, None] - k_pos[None, :]).astype(jnp.float32)
        alibi = -slopes[:, None, None] * dist[None]
        sc = jnp.einsum('bqhmd,bkhmd->bhmqk', qb, k).astype(jnp.float32) * scale
        sc = sc + alibi[None, :, None]
        sc = jnp.where(chunk_allowed(q_pos, k_pos)[None, None, None], sc, NEG_INF)
        p = jax.nn.softmax(sc, axis=-1)
        a = (p[:, :, 0] - lam * p[:, :, 1]).astype(v.dtype)
        return jnp.einsum('bhqk,bkhd->bqhd', a, v)

    nb = s // Q_BLOCK
    o = from_blocks(lax.map(blk, (to_blocks(q), jnp.arange(nb))))
    o = rmsnorm(o, sub_g) * (1.0 - lambda_init)
    return o.reshape(b, s, DIFF_MIX)


def setup_inputs(seed: int = 0) -> dict:
    key = jax.random.key(seed)
    ks = jax.random.split(key, 24)

    def w(k, shape, fan_in):
        return jax.random.normal(k, shape, jnp.float32) * (fan_in ** -0.5)

    def gain(k, shape):
        return 1.0 + 0.02 * jax.random.normal(k, shape, jnp.float32)

    L = DEPTH
    return {
        "x": jax.random.normal(ks[0], (BATCH, SEQ, D_MODEL), jnp.float32),
        "attn_norm_g": gain(ks[1], (L, D_MODEL)),
        "w_in": w(ks[2], (L, D_MODEL, D_IN), D_MODEL),
        "b_gate": 0.01 * jax.random.normal(ks[3], (L, N_BRANCH * D_MODEL), jnp.float32),
        "q_norm_g": gain(ks[4], (L, MLA_Q_RANK)),
        "w_uq": w(ks[5], (L, MLA_Q_RANK, MLA_HEADS * MLA_QK), MLA_Q_RANK),
        "kv_norm_g": gain(ks[6], (L, MLA_KV_RANK)),
        "w_ukv": w(ks[7], (L, MLA_KV_RANK, MLA_HEADS * (MLA_NOPE + MLA_V)), MLA_KV_RANK),
        "lambda_q1": 0.1 * jax.random.normal(ks[8], (L, DIFF_HEAD_DIM), jnp.float32),
        "lambda_k1": 0.1 * jax.random.normal(ks[9], (L, DIFF_HEAD_DIM), jnp.float32),
        "lambda_q2": 0.1 * jax.random.normal(ks[10], (L, DIFF_HEAD_DIM), jnp.float32),
        "lambda_k2": 0.1 * jax.random.normal(ks[11], (L, DIFF_HEAD_DIM), jnp.float32),
        "diff_norm_g": gain(ks[12], (L, DIFF_V)),
        "w_mla_proj": w(ks[13], (L, MLA_MIX, D_MODEL), MLA_MIX),
        "w_diff_proj": w(ks[14], (L, DIFF_MIX, D_MODEL), DIFF_MIX),
        "w_out": w(ks[15], (L, D_MODEL, D_MODEL), D_MODEL),
        "ffn_norm_g": gain(ks[16], (L, D_MODEL)),
        "w_ffn_gate": w(ks[17], (L, D_MODEL, D_FF), D_MODEL),
        "w_ffn_up": w(ks[18], (L, D_MODEL, D_FF), D_MODEL),
        "w_ffn_down": w(ks[19], (L, D_FF, D_MODEL), D_FF),
        "final_norm_g": gain(ks[20], (D_MODEL,)),
    }


def reference(x, attn_norm_g, w_in, b_gate, q_norm_g, w_uq, kv_norm_g, w_ukv,
              lambda_q1, lambda_k1, lambda_q2, lambda_k2, diff_norm_g,
              w_mla_proj, w_diff_proj, w_out, ffn_norm_g, w_ffn_gate, w_ffn_up,
              w_ffn_down, final_norm_g):
    b, s, d = x.shape
    pos = jnp.arange(s)
    cos, sin = rope_tables(pos, MLA_ROPE)
    slopes = jnp.exp2(-8.0 * jnp.arange(1, DIFF_HEADS + 1, dtype=jnp.float32) / DIFF_HEADS)
    split_at = np.cumsum(IN_SIZES)[:-1].tolist()

    for i in range(DEPTH):
        lambda_init = 0.8 - 0.6 * math.exp(-0.3 * i)
        h = rmsnorm(x, attn_norm_g[i])
        proj = h @ w_in[i]
        c_q, c_kv, k_pe, dq, dk, dv, gate_logits = jnp.split(proj, split_at, axis=-1)

        y_mla = mla_branch(c_q, c_kv, k_pe, q_norm_g[i], w_uq[i], kv_norm_g[i], w_ukv[i], cos, sin)
        y_diff = diff_branch(dq, dk, dv, lambda_q1[i], lambda_k1[i], lambda_q2[i], lambda_k2[i],
                             diff_norm_g[i], lambda_init, slopes)

        g = jax.nn.sigmoid((gate_logits + b_gate[i]).astype(jnp.float32)).astype(x.dtype)
        g = g.reshape(b, s, N_BRANCH, d)
        merged = g[:, :, 0] * (y_mla @ w_mla_proj[i]) + g[:, :, 1] * (y_diff @ w_diff_proj[i])
        x = x + merged @ w_out[i]

        h2 = rmsnorm(x, ffn_norm_g[i])
        x = x + (jax.nn.silu(h2 @ w_ffn_gate[i]) * (h2 @ w_ffn_up[i])) @ w_ffn_down[i]

    return rmsnorm(x, final_norm_g)
```

```cpp
#include <hip/hip_runtime.h>
#include <hip/hip_cooperative_groups.h>
#include <cstdio>
#include <cstdint>
namespace cg = cooperative_groups;

#define LAS __attribute__((address_space(3)))
#define DI __device__ __forceinline__
typedef unsigned short bf16_t;
typedef short bf16x8 __attribute__((ext_vector_type(8)));
typedef short s16x4 __attribute__((ext_vector_type(4)));
typedef float f32x4 __attribute__((ext_vector_type(4)));
typedef float f32x16 __attribute__((ext_vector_type(16)));
typedef unsigned u32x4 __attribute__((ext_vector_type(4)));
typedef unsigned u32x2 __attribute__((ext_vector_type(2)));
typedef float f32x2_t __attribute__((ext_vector_type(2)));
typedef __bf16 bf16x2_t __attribute__((ext_vector_type(2)));

constexpr int SEQ = 8192, BATCH = 2, T = BATCH * SEQ, DM = 2048;
constexpr int D_IN = 11584, D_FF = 5632;
constexpr int N_IN_PAD = 11776;
constexpr float EPS = 1e-6f;
constexpr float LOG2E = 1.4426950408889634f;
constexpr float QSCALE_MLA = 0.10411754627697264f;
constexpr float QSCALE_DIFF = 0.12751743082459868f;
constexpr float LAMBDA_INIT = 0.2f;

constexpr size_t SZ_WT_IN = (size_t)N_IN_PAD * 2048 * 2, SZ_WT_UQ = (size_t)3072 * 768 * 2, SZ_WT_UKV = (size_t)4096 * 512 * 2, SZ_WT_SQ = (size_t)2048 * 2048 * 2,
                 SZ_WT_GU = (size_t)2 * D_FF * 2048 * 2, SZ_WT_DN = (size_t)2048 * D_FF * 2;
constexpr size_t WS_WT_IN = 0, WS_WT_UQ = WS_WT_IN + SZ_WT_IN, WS_WT_UKV = WS_WT_UQ + SZ_WT_UQ, WS_WT_MLA = WS_WT_UKV + SZ_WT_UKV, WS_WT_DIFF = WS_WT_MLA + SZ_WT_SQ,
                 WS_WT_OUT = WS_WT_DIFF + SZ_WT_SQ, WS_WT_GU = WS_WT_OUT + SZ_WT_SQ, WS_WT_DN = WS_WT_GU + SZ_WT_GU, WS_ROPE_C = WS_WT_DN + SZ_WT_DN,
                 WS_ROPE_S = WS_ROPE_C + (size_t)SEQ * 32 * 4, WS_SSQ = WS_ROPE_S + (size_t)SEQ * 32 * 4, WS_CTL = WS_SSQ + (size_t)3 * T * 4, WS_BAR = WS_CTL + 4096, WS_KR = WS_BAR + 16384, WS_H = WS_KR + (size_t)T * 64 * 2,
                 WS_R1 = WS_H + (size_t)T * 2048 * 2, WS_R2 = WS_R1 + (size_t)T * (3072 + 4096) * 2, WS_END = WS_R2 + (size_t)T * 2048 * 2;
static_assert(WS_END <= (size_t)512 * 1024 * 1024, "workspace map exceeds 512 MiB");
static_assert(WS_WT_UQ % 256 == 0 && WS_ROPE_C % 256 == 0 && WS_KR % 256 == 0 && WS_H % 256 == 0 && WS_R1 % 256 == 0 && WS_R2 % 256 == 0, "alignment");

constexpr int LDS_BYTES = 147456;

struct Args {
    const float* x; const float* attn_norm_g; const float* w_in; const float* b_gate; const float* q_norm_g; const float* w_uq; const float* kv_norm_g; const float* w_ukv;
    const float* lq1; const float* lk1; const float* lq2; const float* lk2; const float* diff_norm_g; const float* w_mla_proj; const float* w_diff_proj; const float* w_out;
    const float* ffn_norm_g; const float* w_ffn_gate; const float* w_ffn_up; const float* w_ffn_down; const float* final_norm_g;
    float* out; unsigned char* ws;
};

DI unsigned cvtpk(float lo, float hi) { f32x2_t v = {lo, hi}; bf16x2_t b = __builtin_convertvector(v, bf16x2_t); return __builtin_bit_cast(unsigned, b); }
DI float bf_lo(unsigned u) { return __builtin_bit_cast(float, u << 16); }
DI float bf_hi(unsigned u) { return __builtin_bit_cast(float, u & 0xffff0000u); }
template <int MASK> DI float shx(float v, int lane) { return __builtin_bit_cast(float, __builtin_amdgcn_ds_bpermute((lane ^ MASK) << 2, __builtin_bit_cast(int, v))); }
DI float wave_sum(float v, int lane) {
    v += shx<1>(v, lane); v += shx<2>(v, lane); v += shx<4>(v, lane); v += shx<8>(v, lane); v += shx<16>(v, lane); v += shx<32>(v, lane);
    return v;
}
DI float fast_exp2(float x) { return __builtin_amdgcn_exp2f(x); }
DI float fast_rcp(float x) { return __builtin_amdgcn_rcpf(x); }
DI float sigmoidf_(float v) { return fast_rcp(1.0f + fast_exp2(-v * LOG2E)); }
DI void atomic_addf(float* p, float v) { (void)__hip_atomic_fetch_add(p, v, __ATOMIC_RELAXED, __HIP_MEMORY_SCOPE_AGENT); }

namespace pg8 {
constexpr int BM = 256, BK = 64, HALF = 128, HTB = HALF * BK * 2, STAGE_BYTES = 8 * HTB, NXCD = 8, WGM = 4;
DI int lds_byte(int r, int c) { const int st = (r >> 4) * 2 + (c >> 5), rr = r & 15, cc = c & 31, ob = rr * 64 + cc * 2; return st * 1024 + (ob ^ (((ob >> 9) & 1) << 5)); }
DI void stage_rc(int b, int& R, int& C) { const int st = b / 1024, sb = b % 1024, swz = sb ^ (((sb >> 9) & 1) << 5); R = (st >> 1) * 16 + swz / 64; C = (st & 1) * 32 + (swz % 64) / 2; }
DI int perm32(int rho) { const int n = rho >> 4, i = rho & 15; return 8 * (i >> 2) + 4 * n + (i & 3); }

struct Unit { int pm, pn; };
struct Gemm { const bf16_t* A; const bf16_t* Bt; int M, N, K, lda; };

struct StaticOrder {
    int nM, nN, nwg, G, c;
    DI void init(int M, int N, int G_, int c_) { nM = M / BM; nN = N / BM; nwg = nM * nN; G = G_; c = c_; }
    DI bool next(int i, Unit& u) const {
        const long L = (long)i * G + c; if (L >= nwg) return false;
        int wgid = (int)L; { const int q = nwg / NXCD, r = nwg % NXCD, xcd = wgid % NXCD, off = wgid / NXCD; wgid = (xcd < r ? xcd * (q + 1) : r * (q + 1) + (xcd - r) * q) + off; }
        const int nig = WGM * nN, gid = wgid / nig, fm = gid * WGM, gsz = (nM - fm) < WGM ? (nM - fm) : WGM;
        u.pm = fm + ((wgid % nig) % gsz); u.pn = (wgid % nig) / gsz; return true;
    }
    DI void a_ready(const Unit&) const {}
    DI void done(const Unit&) const {}
};

template <class Epi, class Sched>
DI void gemm_phase(LAS unsigned char* lds, const Gemm g, const Sched& S, const Epi& E) {
    int tid_ = threadIdx.x; asm volatile("" : "+v"(tid_));
    const int tid = tid_, wid = __builtin_amdgcn_readfirstlane(tid >> 6), lane = tid & 63, wr = wid >> 2, wc = wid & 3, fr = lane & 15, fq = lane >> 4;
    const int K = g.K, nt = K / BK, lda = g.lda;
    unsigned voffA[2], voffB[2];
#pragma unroll
    for (int i = 0; i < 2; ++i) { int R, C; stage_rc(tid * 16 + i * 8192, R, C); const int Rb = (R & ~31) + perm32(R & 31);
        voffA[i] = (unsigned)(R * lda + C) * 2u; voffB[i] = (unsigned)(Rb * K + C) * 2u; }
    const size_t kstep = (size_t)(BK * 2);
    const size_t hstepA = (size_t)HALF * lda * 2, hstepB = (size_t)HALF * K * 2;
    const size_t tstepA = 2 * hstepA, tstepB = 2 * hstepB;
    const unsigned ldsw = (unsigned)wid * 1024u;
    const int aoff = lds_byte(wr * 64 + fr, fq * 8), boff = lds_byte(wc * 32 + fr, fq * 8);
#define PG8_SA(b, h) (((b) * 2 + (h)) * HTB)
#define PG8_SB(b, h) ((4 + (b) * 2 + (h)) * HTB)
#define PG8_STAGE(bufoff, gbase, voff) do { _Pragma("unroll") for (int _i = 0; _i < 2; ++_i) \
        __builtin_amdgcn_global_load_lds((const unsigned*)((const char*)(gbase) + (voff)[_i]), (LAS unsigned*)(lds + (bufoff) + ldsw + _i * 8192), 16, 0, 0); } while (0)
#define PG8_LDA(dst, b, h) do { _Pragma("unroll") for (int m = 0; m < 4; ++m) _Pragma("unroll") for (int k = 0; k < 2; ++k) dst[m][k] = *(const LAS bf16x8*)(lds + PG8_SA(b, h) + aoff + m * 2048 + k * 1024); } while (0)
#define PG8_LDB(dst, b, h) do { _Pragma("unroll") for (int n = 0; n < 2; ++n) _Pragma("unroll") for (int k = 0; k < 2; ++k) dst[n][k] = *(const LAS bf16x8*)(lds + PG8_SB(b, h) + boff + n * 2048 + k * 1024); } while (0)
#define PG8_MMA(ai, bj, At, Bt) do { __builtin_amdgcn_s_setprio(1); _Pragma("unroll") for (int m = 0; m < 4; ++m) _Pragma("unroll") for (int n = 0; n < 2; ++n) _Pragma("unroll") for (int k = 0; k < 2; ++k) \
        acc[ai][bj][m][n] = __builtin_amdgcn_mfma_f32_16x16x32_bf16(Bt[n][k], At[m][k], acc[ai][bj][m][n], 0, 0, 0); __builtin_amdgcn_s_setprio(0); } while (0)
#define PG8_WAIT_V(n) asm volatile("s_waitcnt vmcnt(" #n ")" ::: "memory")
#define PG8_WAIT_L(n) asm volatile("s_waitcnt lgkmcnt(" #n ")" ::: "memory")
#define PG8_BAR __builtin_amdgcn_s_barrier()
#define PG8_SCHED __builtin_amdgcn_sched_barrier(0)
    Unit cur, nxt; int ui = 0;
    if (!S.next(0, cur)) return;
    f32x4 acc[2][2][4][2];
#pragma unroll
    for (int a = 0; a < 2; ++a)
#pragma unroll
        for (int b = 0; b < 2; ++b)
#pragma unroll
            for (int m = 0; m < 4; ++m)
#pragma unroll
                for (int n = 0; n < 2; ++n) acc[a][b][m][n] = (f32x4){0.f, 0.f, 0.f, 0.f};
    bf16x8 At[4][2], B0[2][2], B1[2][2];
    const char* cA = (const char*)g.A + (size_t)cur.pm * tstepA; const char* cB = (const char*)g.Bt + (size_t)cur.pn * tstepB;
    PG8_STAGE(PG8_SB(0, 0), cB, voffB); PG8_STAGE(PG8_SB(0, 1), cB + hstepB, voffB); PG8_STAGE(PG8_SA(0, 0), cA, voffA); PG8_STAGE(PG8_SA(0, 1), cA + hstepA, voffA);
    if (wr == 1) PG8_BAR;
    PG8_WAIT_V(2); PG8_BAR;
    PG8_STAGE(PG8_SB(1, 0), cB + kstep, voffB); PG8_STAGE(PG8_SA(1, 0), cA + kstep, voffA); PG8_STAGE(PG8_SB(1, 1), cB + hstepB + kstep, voffB);
    PG8_WAIT_V(6); PG8_BAR;
    for (;;) {
        const bool has_next = S.next(ui + 1, nxt);
        const char* nA = has_next ? (const char*)g.A + (size_t)nxt.pm * tstepA : cA; const char* nB = has_next ? (const char*)g.Bt + (size_t)nxt.pn * tstepB : cB;
        for (int t = 0; t < nt; t += 2) {
            const bool last = (t == nt - 2);
            const char* a1 = cA + (size_t)(t + 1) * kstep;
            const char* a2 = last ? nA : cA + (size_t)(t + 2) * kstep; const char* b2 = last ? nB : cB + (size_t)(t + 2) * kstep;
            const char* a3 = a2 + kstep; const char* b3 = b2 + kstep;
            PG8_LDB(B0, 0, 0); PG8_LDB(B1, 0, 1); PG8_SCHED; PG8_LDA(At, 0, 0); PG8_STAGE(PG8_SA(1, 1), a1 + hstepA, voffA);
            PG8_WAIT_V(8); PG8_WAIT_L(0); PG8_BAR; PG8_MMA(0, 0, At, B0); PG8_MMA(0, 1, At, B1); PG8_BAR; PG8_SCHED;
            PG8_LDA(At, 0, 1); PG8_STAGE(PG8_SB(0, 0), b2, voffB); PG8_STAGE(PG8_SB(0, 1), b2 + hstepB, voffB); PG8_STAGE(PG8_SA(0, 0), a2, voffA);
            PG8_WAIT_V(8); PG8_WAIT_L(0); PG8_BAR; PG8_MMA(1, 0, At, B0); PG8_MMA(1, 1, At, B1); PG8_BAR; PG8_SCHED;
            PG8_LDB(B0, 1, 0); PG8_LDB(B1, 1, 1); PG8_SCHED; PG8_LDA(At, 1, 0); PG8_STAGE(PG8_SA(0, 1), a2 + hstepA, voffA);
            PG8_WAIT_V(8); PG8_WAIT_L(0); PG8_BAR; PG8_MMA(0, 0, At, B0); PG8_MMA(0, 1, At, B1); PG8_BAR; PG8_SCHED;
            PG8_LDA(At, 1, 1); PG8_STAGE(PG8_SB(1, 0), b3, voffB); PG8_STAGE(PG8_SB(1, 1), b3 + hstepB, voffB); PG8_STAGE(PG8_SA(1, 0), a3, voffA);
            PG8_WAIT_V(8); PG8_WAIT_L(0); PG8_BAR; PG8_MMA(1, 0, At, B0); PG8_MMA(1, 1, At, B1); PG8_BAR; PG8_SCHED;
        }
        if (wr == 0) PG8_BAR;
        E(acc, cur, wr, wc, fr, fq);
        if (!has_next) break;
#pragma unroll
        for (int a = 0; a < 2; ++a)
#pragma unroll
            for (int b = 0; b < 2; ++b)
#pragma unroll
                for (int m = 0; m < 4; ++m)
#pragma unroll
                    for (int n = 0; n < 2; ++n) acc[a][b][m][n] = (f32x4){0.f, 0.f, 0.f, 0.f};
        cur = nxt; cA = nA; cB = nB; ++ui;
        if (wr == 1) PG8_BAR;
    }
    PG8_WAIT_V(0);
    PG8_BAR;
#undef PG8_SA
#undef PG8_SB
#undef PG8_STAGE
#undef PG8_LDA
#undef PG8_LDB
#undef PG8_MMA
#undef PG8_WAIT_V
#undef PG8_WAIT_L
#undef PG8_BAR
#undef PG8_SCHED
}
}

using pg8::Unit;
typedef const f32x4 (&AccRef)[2][2][4][2];

DI void store8_bf16(bf16_t* p, f32x4 v0, f32x4 v1) {
    u32x4 w; w.x = cvtpk(v0[0], v0[1]); w.y = cvtpk(v0[2], v0[3]); w.z = cvtpk(v1[0], v1[1]); w.w = cvtpk(v1[2], v1[3]);
    *(u32x4*)p = w;
}
DI void load8_bf16(const bf16_t* p, f32x4& v0, f32x4& v1) {
    const u32x4 w = *(const u32x4*)p;
    v0 = (f32x4){bf_lo(w.x), bf_hi(w.x), bf_lo(w.y), bf_hi(w.y)}; v1 = (f32x4){bf_lo(w.z), bf_hi(w.z), bf_lo(w.w), bf_hi(w.w)};
}
DI float dot4(f32x4 v) { return (v[0] * v[0] + v[1] * v[1]) + (v[2] * v[2] + v[3] * v[3]); }

#define EPI_HDR static constexpr bool PERM = true, AFTER_DRAIN = false;
DI void wave16_atomic_max(unsigned* p, float mv, int fr, int fq) {
    const int ln = fr | (fq << 4);
    mv = __builtin_fmaxf(mv, shx<1>(mv, ln)); mv = __builtin_fmaxf(mv, shx<2>(mv, ln)); mv = __builtin_fmaxf(mv, shx<4>(mv, ln)); mv = __builtin_fmaxf(mv, shx<8>(mv, ln));
    if (fr == 0 && fq == 0) (void)__hip_atomic_fetch_max(p, __builtin_bit_cast(unsigned, mv), __ATOMIC_RELAXED, __HIP_MEMORY_SCOPE_AGENT);
}
constexpr int CW_QCTR = 256, CW_NQ = 320, CW_NK = 512, CW_NKR = 704;
#define FOR_ROWS _Pragma("unroll") for (int ai = 0; ai < 2; ++ai) _Pragma("unroll") for (int m = 0; m < 4; ++m)
#define FOR_BJ _Pragma("unroll") for (int bj = 0; bj < 2; ++bj)

struct EpiIn { EPI_HDR
    bf16_t* cqkv; bf16_t* dqkv; bf16_t* gates; bf16_t* kr; float* ssq_q; float* ssq_kv; const float* b_gate; const float* rcos; const float* rsin; unsigned* nrm;
    DI void operator()(AccRef acc, const Unit& u, int wr, int wc, int fr, int fq) const {
        const int pn = u.pn, row0 = u.pm * 256 + wr * 64 + fr, c8 = wc * 32 + 8 * fq;
        if (pn < 5) {
            float* ssq = pn < 3 ? ssq_q : ssq_kv;
            FOR_ROWS { const int row = row0 + ai * 128 + m * 16; float s = 0.f;
                FOR_BJ { const f32x4 v0 = acc[ai][bj][m][0], v1 = acc[ai][bj][m][1]; s += dot4(v0) + dot4(v1);
                    store8_bf16(cqkv + (size_t)row * 1280 + pn * 256 + bj * 128 + c8, v0, v1); }
                s += shx<16>(s, fr | (fq << 4)); s += shx<32>(s, fr | (fq << 4));
                if (fq == 0) atomic_addf(ssq + row, s); }
        } else if (pn < 21) {
            const float sc = pn < 13 ? QSCALE_DIFF : 1.0f;
            float mxp[2] = {0.f, 0.f};
            FOR_ROWS { const int row = row0 + ai * 128 + m * 16;
                FOR_BJ { const f32x4 v0 = acc[ai][bj][m][0] * sc, v1 = acc[ai][bj][m][1] * sc; float s = dot4(v0) + dot4(v1);
                    s += shx<16>(s, fr | (fq << 4)); s += shx<32>(s, fr | (fq << 4)); mxp[bj] = __builtin_fmaxf(mxp[bj], s);
                    store8_bf16(dqkv + (size_t)row * 6144 + (pn - 5) * 256 + bj * 128 + c8, v0, v1); } }
            const int sel = (pn - 5) >> 3, head = (pn - 5) & 7, bb = u.pm >> 5;
            FOR_BJ { float mv = mxp[bj]; mv = __builtin_fmaxf(mv, shx<1>(mv, fr | (fq << 4))); mv = __builtin_fmaxf(mv, shx<2>(mv, fr | (fq << 4))); mv = __builtin_fmaxf(mv, shx<4>(mv, fr | (fq << 4))); mv = __builtin_fmaxf(mv, shx<8>(mv, fr | (fq << 4)));
                if (fr == 0 && fq == 0) (void)__hip_atomic_fetch_max(nrm + ((((bb * 8 + head) * 2 + bj) * 2 + sel) * 4 + wc), __builtin_bit_cast(unsigned, mv), __ATOMIC_RELAXED, __HIP_MEMORY_SCOPE_AGENT); }
        } else if (pn < 29) {
            FOR_ROWS { const int row = row0 + ai * 128 + m * 16;
                FOR_BJ store8_bf16(dqkv + (size_t)row * 6144 + (pn - 5) * 256 + bj * 128 + c8, acc[ai][bj][m][0], acc[ai][bj][m][1]); }
        } else if (pn < 45) {
            f32x4 b0[2], b1[2];
            FOR_BJ { const float* bp = b_gate + (pn - 29) * 256 + bj * 128 + c8; b0[bj] = *(const f32x4*)bp; b1[bj] = *(const f32x4*)(bp + 4); }
            FOR_ROWS { const int row = row0 + ai * 128 + m * 16;
                FOR_BJ { f32x4 v0 = acc[ai][bj][m][0] + b0[bj], v1 = acc[ai][bj][m][1] + b1[bj];
#pragma unroll
                    for (int e = 0; e < 4; ++e) { v0[e] = sigmoidf_(v0[e]); v1[e] = sigmoidf_(v1[e]); }
                    store8_bf16(gates + (size_t)row * 4096 + (pn - 29) * 256 + bj * 128 + c8, v0, v1); } }
        } else {
            if (wc == 0) {
                float mxr = 0.f;
                FOR_ROWS { const int row = row0 + ai * 128 + m * 16, pos = row & (SEQ - 1);
                    f32x4 o1[2], o2[2]; float sq = 0.f;
#pragma unroll
                    for (int n = 0; n < 2; ++n) { const f32x4 c = *(const f32x4*)(rcos + pos * 32 + 8 * fq + 4 * n), s = *(const f32x4*)(rsin + pos * 32 + 8 * fq + 4 * n);
                        const f32x4 x1 = acc[ai][0][m][n], x2 = acc[ai][1][m][n]; o1[n] = x1 * c - x2 * s; o2[n] = x2 * c + x1 * s; sq += dot4(o1[n]) + dot4(o2[n]); }
                    sq += shx<16>(sq, fr | (fq << 4)); sq += shx<32>(sq, fr | (fq << 4)); mxr = __builtin_fmaxf(mxr, sq);
                    store8_bf16(kr + (size_t)row * 64 + 8 * fq, o1[0], o1[1]); store8_bf16(kr + (size_t)row * 64 + 32 + 8 * fq, o2[0], o2[1]); }
                wave16_atomic_max(nrm + CW_NKR + (u.pm >> 5), mxr, fr, fq);
            }
        }
    }
};
struct EpiUQ { EPI_HDR
    bf16_t* Q; const float* ssq_q; const float* rcos; const float* rsin; unsigned* ctl;
    DI void operator()(AccRef acc, const Unit& u, int wr, int wc, int fr, int fq) const {
        const int pn = u.pn, row0 = u.pm * 256 + wr * 64 + fr, c8 = wc * 32 + 8 * fq;
        float mxp[2] = {0.f, 0.f};
        FOR_ROWS { const int row = row0 + ai * 128 + m * 16; const float rs = __builtin_amdgcn_rsqf(ssq_q[row] * (1.0f / 768.0f) + EPS) * QSCALE_MLA;
            if (pn < 8) {
                FOR_BJ { const f32x4 v0 = acc[ai][bj][m][0] * rs, v1 = acc[ai][bj][m][1] * rs; float sq = dot4(v0) + dot4(v1);
                    sq += shx<16>(sq, fr | (fq << 4)); sq += shx<32>(sq, fr | (fq << 4)); mxp[bj] = __builtin_fmaxf(mxp[bj], sq);
                    store8_bf16(Q + (size_t)row * 3072 + (2 * pn + bj) * 192 + c8, v0, v1); }
            } else {
                const int head = 4 * (pn - 8) + wc, pos = row & (SEQ - 1);
                f32x4 o1[2], o2[2]; float sq = 0.f;
#pragma unroll
                for (int n = 0; n < 2; ++n) { const f32x4 c = *(const f32x4*)(rcos + pos * 32 + 8 * fq + 4 * n), s = *(const f32x4*)(rsin + pos * 32 + 8 * fq + 4 * n);
                    const f32x4 x1 = acc[ai][0][m][n] * rs, x2 = acc[ai][1][m][n] * rs; o1[n] = x1 * c - x2 * s; o2[n] = x2 * c + x1 * s; sq += dot4(o1[n]) + dot4(o2[n]); }
                sq += shx<16>(sq, fr | (fq << 4)); sq += shx<32>(sq, fr | (fq << 4)); mxp[0] = __builtin_fmaxf(mxp[0], sq);
                store8_bf16(Q + (size_t)row * 3072 + head * 192 + 128 + 8 * fq, o1[0], o1[1]); store8_bf16(Q + (size_t)row * 3072 + head * 192 + 160 + 8 * fq, o2[0], o2[1]);
            } }
        const int bb = u.pm >> 5;
        if (pn < 8) { FOR_BJ wave16_atomic_max(ctl + CW_NQ + ((bb * 16 + 2 * pn + bj) * 5 + wc), mxp[bj], fr, fq); }
        else wave16_atomic_max(ctl + CW_NQ + ((bb * 16 + 4 * (pn - 8) + wc) * 5 + 4), mxp[0], fr, fq);
    }
};
struct EpiUKV { EPI_HDR
    bf16_t* KV; const float* ssq_kv; unsigned* ctl;
    DI void operator()(AccRef acc, const Unit& u, int wr, int wc, int fr, int fq) const {
        const int row0 = u.pm * 256 + wr * 64 + fr, c8 = wc * 32 + 8 * fq;
        float mxk = 0.f;
        FOR_ROWS { const int row = row0 + ai * 128 + m * 16; const float rs = __builtin_amdgcn_rsqf(ssq_kv[row] * (1.0f / 512.0f) + EPS);
            FOR_BJ { const f32x4 v0 = acc[ai][bj][m][0] * rs, v1 = acc[ai][bj][m][1] * rs;
                if (bj == 0) { float sq = dot4(v0) + dot4(v1); sq += shx<16>(sq, fr | (fq << 4)); sq += shx<32>(sq, fr | (fq << 4)); mxk = __builtin_fmaxf(mxk, sq); }
                store8_bf16(KV + (size_t)row * 4096 + u.pn * 256 + bj * 128 + c8, v0, v1); } }
        wave16_atomic_max(ctl + CW_NK + (((u.pm >> 5) * 16 + u.pn) * 4 + wc), mxk, fr, fq);
    }
};
struct EpiMixA { EPI_HDR
    bf16_t* merged; const bf16_t* gates;
    DI void operator()(AccRef acc, const Unit& u, int wr, int wc, int fr, int fq) const {
        const int row0 = u.pm * 256 + wr * 64 + fr, c8 = wc * 32 + 8 * fq;
        FOR_ROWS { const int row = row0 + ai * 128 + m * 16;
            FOR_BJ { const int col = u.pn * 256 + bj * 128 + c8; f32x4 g0, g1; load8_bf16(gates + (size_t)row * 4096 + col, g0, g1);
                store8_bf16(merged + (size_t)row * 2048 + col, acc[ai][bj][m][0] * g0, acc[ai][bj][m][1] * g1); } }
    }
};
struct EpiMixB { EPI_HDR
    const bf16_t* gates; bf16_t* merged;
    DI void operator()(AccRef acc, const Unit& u, int wr, int wc, int fr, int fq) const {
        const int row0 = u.pm * 256 + wr * 64 + fr, c8 = wc * 32 + 8 * fq;
        FOR_ROWS { const int row = row0 + ai * 128 + m * 16;
            FOR_BJ { const int col = u.pn * 256 + bj * 128 + c8; f32x4 g0, g1; load8_bf16(gates + (size_t)row * 4096 + 2048 + col, g0, g1);
                f32x4 t0, t1; load8_bf16(merged + (size_t)row * 2048 + col, t0, t1);
                store8_bf16(merged + (size_t)row * 2048 + col, t0 + acc[ai][bj][m][0] * g0, t1 + acc[ai][bj][m][1] * g1); } }
    }
};
template <bool WITH_B> struct EpiRes { EPI_HDR
    const float* base; float* out; bf16_t* outb; float* ssq;
    DI void operator()(AccRef acc, const Unit& u, int wr, int wc, int fr, int fq) const {
        const int row0 = u.pm * 256 + wr * 64 + fr, c8 = wc * 32 + 8 * fq;
        FOR_ROWS { const int row = row0 + ai * 128 + m * 16; float s = 0.f;
            FOR_BJ { const size_t off = (size_t)row * 2048 + u.pn * 256 + bj * 128 + c8;
                const f32x4 v0 = *(const f32x4*)(base + off) + acc[ai][bj][m][0], v1 = *(const f32x4*)(base + off + 4) + acc[ai][bj][m][1];
                *(f32x4*)(out + off) = v0; *(f32x4*)(out + off + 4) = v1;
                if (WITH_B) { store8_bf16(outb + off, v0, v1); s += dot4(v0) + dot4(v1); } }
            if (WITH_B) { s += shx<16>(s, fr | (fq << 4)); s += shx<32>(s, fr | (fq << 4)); if (fq == 0) atomic_addf(ssq + row, s); } }
    }
};
struct EpiGU { EPI_HDR
    bf16_t* U; const float* ssq;
    DI void operator()(AccRef acc, const Unit& u, int wr, int wc, int fr, int fq) const {
        const int row0 = u.pm * 256 + wr * 64 + fr, c8 = wc * 32 + 8 * fq;
        FOR_ROWS { const int row = row0 + ai * 128 + m * 16; const float rs = __builtin_amdgcn_rsqf(ssq[row] * (1.0f / 2048.0f) + EPS);
            f32x4 o[2];
#pragma unroll
            for (int n = 0; n < 2; ++n) { const f32x4 gv = acc[ai][0][m][n] * rs, uv = acc[ai][1][m][n] * rs;
#pragma unroll
                for (int e = 0; e < 4; ++e) o[n][e] = gv[e] * sigmoidf_(gv[e]) * uv[e]; }
            store8_bf16(U + (size_t)row * D_FF + u.pn * 128 + c8, o[0], o[1]); }
    }
};

namespace att {
template <bool DIFF> struct Cfg;
template <> struct Cfg<false> { static constexpr int NKS = 12, NDT = 4, KSTR = 400, VSTR = 320, NST = 5; };
template <> struct Cfg<true>  { static constexpr int NKS = 8,  NDT = 8, KSTR = 528, VSTR = 576, NST = 8; };
DI f32x16 mfma32(bf16x8 a, bf16x8 b, f32x16 c) { return __builtin_amdgcn_mfma_f32_32x32x16_bf16(a, b, c, 0, 0, 0); }
DI s16x4 vtr(const LAS unsigned char* p) { return __builtin_bit_cast(s16x4, __builtin_amdgcn_ds_read_tr16_b64_v4i16((LAS s16x4*)p)); }
DI bf16x8 pack8(const f32x16& x, int s) {
    u32x4 p; p.x = cvtpk(x[8 * s + 0], x[8 * s + 1]); p.y = cvtpk(x[8 * s + 2], x[8 * s + 3]); p.z = cvtpk(x[8 * s + 4], x[8 * s + 5]); p.w = cvtpk(x[8 * s + 6], x[8 * s + 7]);
    return __builtin_bit_cast(bf16x8, p);
}

struct Tensors {
    const bf16_t* Q;   int q_pitch;
    const bf16_t* K;   int k_pitch;
    const bf16_t* V;
    const bf16_t* KR;
    bf16_t* Y;
    const float* sub_g; float lam;
    const unsigned* nrm; unsigned* qctr;
};

template <bool DIFF, bool NOMAX>
DI void unit(LAS unsigned char* lds, const Tensors& Tn, int b, int hd, int qb) {
    typedef Cfg<DIFF> C;
    constexpr int NKS = C::NKS, NDT = C::NDT, KSTR = C::KSTR, VSTR = C::VSTR, NST = C::NST;
    constexpr int K_BYTES = 64 * KSTR, V_BYTES = 64 * VSTR, STAGE = K_BYTES + V_BYTES;
    int tid_ = threadIdx.x; asm volatile("" : "+v"(tid_));
    const int tid = tid_, w = __builtin_amdgcn_readfirstlane(tid >> 6), lane = tid & 63, r = lane & 31, h = lane >> 5;
    const int wq = DIFF ? (w & 3) : w, map = DIFF ? (w >> 2) : 0;
    const int q0 = DIFF ? qb * 128 + 32 * wq : qb * 256 + 32 * wq;
    const int need = (q0 >> 6) + 1;
    const int ntiles = DIFF ? 2 * qb + 2 : 4 * qb + 4;
    int jst = 0, jbeg = 0;
    const float sl2 = DIFF ? __builtin_amdgcn_exp2f(-(float)(hd + 1)) * LOG2E : 0.f;
    if (DIFF) {
        float wd[2];
#pragma unroll
        for (int mp = 0; mp < 2; ++mp) { const unsigned* nq = Tn.nrm + (((b * 8 + hd) * 2 + mp) * 2 + 0) * 4; const unsigned* nk = nq + 4;
            const float sq = (__builtin_bit_cast(float, nq[0]) + __builtin_bit_cast(float, nq[1])) + (__builtin_bit_cast(float, nq[2]) + __builtin_bit_cast(float, nq[3]));
            const float sk = (__builtin_bit_cast(float, nk[0]) + __builtin_bit_cast(float, nk[1])) + (__builtin_bit_cast(float, nk[2]) + __builtin_bit_cast(float, nk[3]));
            const float B2 = __builtin_sqrtf(sq * sk) * 1.02f;
            wd[mp] = (152.0f + 2.0f * B2) / sl2; }
        const float lim = (float)(q0 - 63) - wd[map], limb = (float)(qb * 128 - 63) - __builtin_fmaxf(wd[0], wd[1]);
        jst = lim > 0.f ? (int)__builtin_ceilf(lim * (1.0f / 64.0f)) : 0; jbeg = limb > 0.f ? (int)__builtin_ceilf(limb * (1.0f / 64.0f)) : 0;
        jst = __builtin_amdgcn_readfirstlane(jst); jbeg = __builtin_amdgcn_readfirstlane(jbeg);
        if (jst < jbeg) jst = jbeg;
    }
    const size_t tok0 = (size_t)b * SEQ;

    if (w >= 4) __builtin_amdgcn_s_setprio(1);
    bf16x8 qf[NKS];
    {
        const bf16_t* qp = Tn.Q + (tok0 + q0 + r) * Tn.q_pitch + (DIFF ? hd * 256 + map * 128 : hd * 192) + 8 * h;
#pragma unroll
        for (int ks = 0; ks < NKS; ++ks) qf[ks] = *(const bf16x8*)(qp + 16 * ks);
    }
    constexpr int NP = STAGE / 1024, NPW = (NP + 7) / 8, KCH = DIFF ? 32 : 24, VCH = DIFF ? 32 : 16;
    unsigned goff[NPW];
#pragma unroll
    for (int i = 0; i < NPW; ++i) {
        const int ob = (w + 8 * i) * 1024 + lane * 16; unsigned off;
        if (ob < K_BYTES) { const int row = ob / KSTR, ch = (ob % KSTR) / 16;
            if (DIFF) off = (ch < KCH) ? (unsigned)((row * 6144 + 2048 + hd * 256 + ch * 8) * 2) : 0u;
            else off = (ch < 16) ? (unsigned)((row * 4096 + hd * 256 + ch * 8) * 2) : (ch < KCH ? (0x80000000u | (unsigned)((row * 64 + (ch - 16) * 8) * 2)) : 0u);
        } else { const int o2 = ob - K_BYTES, row = o2 / VSTR, ch = (o2 % VSTR) / 16;
            if (DIFF) off = (ch < VCH && row < 64) ? (unsigned)((row * 6144 + 4096 + hd * 256 + ch * 8) * 2) : 0u;
            else off = (ch < VCH && row < 64) ? (unsigned)((row * 4096 + hd * 256 + 128 + ch * 8) * 2) : 0u;
        }
        goff[i] = off;
    }
    const char* kvbase = (const char*)(DIFF ? Tn.Q : Tn.K) + tok0 * (DIFF ? 6144 : 4096) * 2;
    const char* krbase = DIFF ? kvbase : (const char*)Tn.KR + tok0 * 64 * 2;
#define ATT_ISSUE(j, buf) do { const char* kvb = kvbase + (size_t)(j) * 64 * (DIFF ? 6144 : 4096) * 2; const char* krb = krbase + (size_t)(j) * 64 * 64 * 2; \
        _Pragma("unroll") for (int i = 0; i < NPW; ++i) { if (w + 8 * i < NP) { \
            const char* src = (!DIFF && (goff[i] & 0x80000000u)) ? krb + (goff[i] & 0x7fffffffu) : kvb + goff[i]; \
            __builtin_amdgcn_global_load_lds((const unsigned*)src, (LAS unsigned*)(lds + (buf) * STAGE + (w + 8 * i) * 1024), 16, 0, 0); } } } while (0)

    f32x16 o[NDT];
#pragma unroll
    for (int dt = 0; dt < NDT; ++dt)
#pragma unroll
        for (int e = 0; e < 16; ++e) o[dt][e] = 0.f;
    float mrow = 0.f, lrow = 0.f;
    const int i16 = lane & 15, tq = i16 >> 2, tp = i16 & 3, g16 = (lane >> 4) & 1;
    const unsigned koff = r * KSTR + h * 16 + (DIFF ? map * 256 : 0);
    const unsigned voff = K_BYTES + (4 * h + tq) * VSTR + (16 * g16 + 4 * tp) * 2;

    constexpr int NSTG = DIFF ? 2 : 3;
    const bool full_w = (w + 8 * (NPW - 1) < NP);
    int sb = 0;
    ATT_ISSUE(jbeg, 0);
    if (NSTG == 3 && jbeg + 1 < ntiles) ATT_ISSUE(jbeg + 1, 1);
    if (NSTG == 3 && jbeg + 1 < ntiles) { if (full_w) asm volatile("s_waitcnt vmcnt(%0)" :: "n"(NPW) : "memory"); else asm volatile("s_waitcnt vmcnt(%0)" :: "n"(NPW - 1) : "memory"); }
    else asm volatile("s_waitcnt vmcnt(0)" ::: "memory");
    __builtin_amdgcn_s_barrier();
    for (int j = jbeg; j < ntiles; ++j) {
        const int sbn = (sb + NSTG - 1 >= NSTG) ? sb - 1 : sb + NSTG - 1;
        if (j + NSTG - 1 < ntiles) ATT_ISSUE(j + NSTG - 1, sbn);
        if (j >= jst && j < need) {
            const LAS unsigned char* kb = lds + sb * STAGE + koff;
            const unsigned vba = (unsigned)(uintptr_t)(lds + sb * STAGE + voff);
            constexpr int DK = DIFF ? (NOMAX ? 4 : 2) : 4, DV = DIFF ? (NOMAX ? 2 : 1) : 4, NPV = 2 * NDT;
            bf16x8 kf[DK]; s16x4 vlo[DV], vhi[DV];
#define SGB(mask, n) __builtin_amdgcn_sched_group_barrier(mask, n, 0)
#define LDK(hf_, ks_) (*(const LAS bf16x8*)(kb + (hf_) * 32 * KSTR + (ks_) * 32))
#define VTR(dst_, off_) asm volatile("ds_read_b64_tr_b16 %0, %1 offset:%c2" : "=v"(dst_) : "v"(vba), "i"(off_) : "memory")
#define LDV(i_, hf_) do { VTR(vlo[(i_) % DV], (16 * (2 * (hf_) + ((i_) & 1))) * VSTR + 64 * ((i_) >> 1)); VTR(vhi[(i_) % DV], (16 * (2 * (hf_) + ((i_) & 1)) + 8) * VSTR + 64 * ((i_) >> 1)); } while (0)
#define VWAIT(n_, a_, b_) asm volatile("s_waitcnt lgkmcnt(%c2)" : "+v"(a_), "+v"(b_) : "i"(n_) : "memory")
#pragma unroll
            for (int i = 0; i < DK; ++i) kf[i] = LDK(0, i);
            SGB(0x100, DK);
#pragma unroll
            for (int hf = 0; hf < 2; ++hf) {
                const bool offd = DIFF && (j < need - 1);
                f32x16 sc;
                if (offd) {
                    const float A = sl2 * (float)(64 * j + 32 * hf + 4 * h - q0) - (NOMAX ? 0.f : mrow);
                    float tg[4] = {A, __builtin_fmaf(sl2, 8.f, A), __builtin_fmaf(sl2, 16.f, A), __builtin_fmaf(sl2, 24.f, A)};
#pragma unroll
                    for (int g = 0; g < 4; ++g) asm volatile("" : "+v"(tg[g]));
#pragma unroll
                    for (int e = 0; e < 16; ++e) sc[e] = __builtin_fmaf(sl2, (float)(e & 3), tg[e >> 2]);
                } else {
                    const float base = (DIFF ? sl2 * (float)r : 0.f) - (NOMAX ? 0.f : mrow);
#pragma unroll
                    for (int e = 0; e < 16; ++e) sc[e] = base;
                }
#pragma unroll
                for (int ks = 0; ks < NKS; ++ks) {
                    sc = mfma32(kf[ks % DK], qf[ks], sc);
                    if (ks + DK < NKS) kf[ks % DK] = LDK(hf, ks + DK);
                }
#pragma unroll
                for (int ks = 0; ks < NKS; ++ks) { SGB(0x8, 1); if (ks + DK < NKS) SGB(0x100, 1); }
                __builtin_amdgcn_sched_barrier(0);
#pragma unroll
                for (int i = 0; i < DV; ++i) LDV(i, hf);
                if (DIFF && !offd) {
                    const float qk = (float)(q0 + r - 64 * j - 4 * h - 32 * hf);
                    float tq[4] = {qk, qk - 8.f, qk - 16.f, qk - 24.f};
#pragma unroll
                    for (int g = 0; g < 4; ++g) asm volatile("" : "+v"(tq[g]));
#pragma unroll
                    for (int e = 0; e < 16; ++e) sc[e] = __builtin_fmaf(-sl2, __builtin_fabsf(tq[e >> 2] - (float)(e & 3)), sc[e]);
                }
                float mx = sc[0];
                if (!NOMAX) {
#pragma unroll
                for (int e = 1; e < 16; ++e) mx = __builtin_fmaxf(mx, sc[e]);
                { auto rr = __builtin_amdgcn_permlane32_swap(__builtin_bit_cast(unsigned, mx), __builtin_bit_cast(unsigned, mx), false, false);
                  mx = __builtin_fmaxf(__builtin_bit_cast(float, rr[0]), __builtin_bit_cast(float, rr[1])); }
                }
                const bool first = (j == jst) && (hf == 0);
                if (!NOMAX && (first || __any(mx > 8.0f))) {
                    const float mn = first ? mx : __builtin_fmaxf(mx, 0.f), al = first ? 1.0f : fast_exp2(-mn);
#pragma unroll
                    for (int dt = 0; dt < NDT; ++dt) o[dt] = o[dt] * al;
                    lrow *= al; mrow += mn;
#pragma unroll
                    for (int e = 0; e < 16; ++e) sc[e] -= mn;
                }
                f32x2_t ps2 = {0.f, 0.f};
#pragma unroll
                for (int e = 0; e < 16; e += 2) { sc[e] = fast_exp2(sc[e]); sc[e + 1] = fast_exp2(sc[e + 1]); ps2 += (f32x2_t){sc[e], sc[e + 1]}; }
                lrow += ps2.x + ps2.y;
                bf16x8 pb[2]; pb[0] = pack8(sc, 0); pb[1] = pack8(sc, 1);
#pragma unroll
                for (int i = 0; i < NPV; ++i) {
                    VWAIT(2 * ((NPV - 1 - i) < (DV - 1) ? (NPV - 1 - i) : (DV - 1)), vlo[i % DV], vhi[i % DV]);
                    const bf16x8 vf = __builtin_shufflevector(vlo[i % DV], vhi[i % DV], 0, 1, 2, 3, 4, 5, 6, 7);
                    o[i >> 1] = mfma32(vf, pb[i & 1], o[i >> 1]);
                    if (i + DV < NPV) LDV(i + DV, hf);
                }
                __builtin_amdgcn_sched_barrier(0);
                if (hf == 0) {
#pragma unroll
                    for (int i = 0; i < DK; ++i) kf[i] = LDK(1, i);
                    SGB(0x100, DK);
                }
            }
#undef SGB
#undef LDK
#undef VTR
#undef LDV
#undef VWAIT
        }
        if (NSTG == 3 && j + 2 < ntiles) { if (full_w) asm volatile("s_waitcnt vmcnt(%0) lgkmcnt(0)" :: "n"(NPW) : "memory"); else asm volatile("s_waitcnt vmcnt(%0) lgkmcnt(0)" :: "n"(NPW - 1) : "memory"); }
        else asm volatile("s_waitcnt vmcnt(0) lgkmcnt(0)" ::: "memory");
        __builtin_amdgcn_s_barrier();
        sb = (sb + 1 == NSTG) ? 0 : sb + 1;
    }
#undef ATT_ISSUE
    __builtin_amdgcn_s_setprio(0);
    int tid2_ = threadIdx.x; asm volatile("" : "+v"(tid2_));
    const int lane2 = tid2_ & 63, w2 = __builtin_amdgcn_readfirstlane(tid2_ >> 6), wq2 = DIFF ? (w2 & 3) : w2, map2 = DIFF ? (w2 >> 2) : 0;
    const int r2 = lane2 & 31, h2 = lane2 >> 5, q02 = DIFF ? qb * 128 + 32 * wq2 : qb * 256 + 32 * wq2;
    const float ltot = lrow + shx<32>(lrow, lane2);
    const float inv = 1.0f / ltot;
    if (!DIFF) {
        bf16_t* yp = Tn.Y + (tok0 + q02 + r2) * 2048 + hd * 128 + 4 * h2;
#pragma unroll
        for (int dt = 0; dt < NDT; ++dt)
#pragma unroll
            for (int g = 0; g < 4; ++g) { u32x2 pk; pk.x = cvtpk(o[dt][4 * g] * inv, o[dt][4 * g + 1] * inv); pk.y = cvtpk(o[dt][4 * g + 2] * inv, o[dt][4 * g + 3] * inv);
                *(u32x2*)(yp + 32 * dt + 8 * g) = pk; }
    } else {
        LAS float* X = (LAS float*)lds;
        if (map2 == 1) {
#pragma unroll
            for (int dt = 0; dt < NDT; ++dt)
#pragma unroll
                for (int e = 0; e < 16; ++e) X[(wq2 * 128 + dt * 16 + e) * 64 + lane2] = o[dt][e] * inv;
        }
        __syncthreads();
        if (map2 == 0) {
            float ss = 0.f;
#pragma unroll
            for (int dt = 0; dt < NDT; ++dt)
#pragma unroll
                for (int e = 0; e < 16; ++e) { const float v = o[dt][e] * inv - Tn.lam * X[(wq2 * 128 + dt * 16 + e) * 64 + lane2]; o[dt][e] = v; ss += v * v; }
            ss += shx<32>(ss, lane2);
            const float rs = __builtin_amdgcn_rsqf(ss * (1.0f / 256.0f) + EPS) * (1.0f - LAMBDA_INIT);
            bf16_t* yp = Tn.Y + (tok0 + q02 + r2) * 2048 + hd * 256 + 4 * h2;
#pragma unroll
            for (int dt = 0; dt < NDT; ++dt)
#pragma unroll
                for (int g = 0; g < 4; ++g) { const f32x4 gg = *(const f32x4*)(Tn.sub_g + 32 * dt + 8 * g + 4 * h2);
                    u32x2 pk; pk.x = cvtpk(o[dt][4 * g] * rs * gg[0], o[dt][4 * g + 1] * rs * gg[1]); pk.y = cvtpk(o[dt][4 * g + 2] * rs * gg[2], o[dt][4 * g + 3] * rs * gg[3]);
                    *(u32x2*)(yp + 32 * dt + 8 * g) = pk; }
        }
        __syncthreads();
    }
}

template <bool DIFF>
DI float score_bound(const Tensors& Tn, int b, int hd) {
    float bound;
    if (DIFF) {
        bound = 0.f;
#pragma unroll
        for (int mp = 0; mp < 2; ++mp) { const unsigned* nq = Tn.nrm + (((b * 8 + hd) * 2 + mp) * 2 + 0) * 4; const unsigned* nk = nq + 4;
            const float sq = (__builtin_bit_cast(float, nq[0]) + __builtin_bit_cast(float, nq[1])) + (__builtin_bit_cast(float, nq[2]) + __builtin_bit_cast(float, nq[3]));
            const float sk = (__builtin_bit_cast(float, nk[0]) + __builtin_bit_cast(float, nk[1])) + (__builtin_bit_cast(float, nk[2]) + __builtin_bit_cast(float, nk[3]));
            bound = __builtin_fmaxf(bound, __builtin_sqrtf(sq * sk) * 1.02f); }
    } else {
        const unsigned* nq = Tn.nrm + CW_NQ + (b * 16 + hd) * 5; const unsigned* nk = Tn.nrm + CW_NK + (b * 16 + hd) * 4;
        const float sq = (__builtin_bit_cast(float, nq[0]) + __builtin_bit_cast(float, nq[1])) + (__builtin_bit_cast(float, nq[2]) + __builtin_bit_cast(float, nq[3])) + __builtin_bit_cast(float, nq[4]);
        const float sk = (__builtin_bit_cast(float, nk[0]) + __builtin_bit_cast(float, nk[1])) + (__builtin_bit_cast(float, nk[2]) + __builtin_bit_cast(float, nk[3])) + __builtin_bit_cast(float, Tn.nrm[CW_NKR + b]);
        bound = __builtin_sqrtf(sq * sk) * 1.02f;
    }
    return __builtin_bit_cast(float, __builtin_amdgcn_readfirstlane(__builtin_bit_cast(int, bound)));
}

template <bool DIFF>
DI void phase(LAS unsigned char* lds, const Tensors& Tn) {
    constexpr int NQ = DIFF ? 64 : 32, NBH = DIFF ? 16 : 32, HALFQ = NQ / 2, NPAIR = NBH * HALFQ;
    const int G = gridDim.x, c = blockIdx.x;
    if (DIFF) {
        LAS unsigned* slot = (LAS unsigned*)(lds + LDS_BYTES - 64);
        if (threadIdx.x == 0) slot[1] = 0u;
        __syncthreads();
        for (;;) {
            const unsigned qi = slot[1];
            if (qi >= 8u) break;
            const int q = (int)((blockIdx.x + qi) & 7u);
            if (threadIdx.x == 0) slot[0] = __hip_atomic_fetch_add(Tn.qctr + 16 * q, 1u, __ATOMIC_RELAXED, __HIP_MEMORY_SCOPE_AGENT);
            __syncthreads();
            const unsigned uu = slot[0];
            __syncthreads();
            if (uu >= 128u) { if (threadIdx.x == 0) slot[1] = qi + 1u; __syncthreads(); continue; }
            const int bq = q >> 2, hq = (uu & 1u) ? 7 - (q & 3) : (q & 3), qbx = 63 - (int)(uu >> 1);
            if (score_bound<DIFF>(Tn, bq, hq) < 75.0f) unit<DIFF, true>(lds, Tn, bq, hq, qbx); else unit<DIFF, false>(lds, Tn, bq, hq, qbx);
        }
        return;
    }
    for (int p = c; p < NPAIR; p += G) {
        int bh, a;
        if (G == 256) { const int xcd = c & 7, idx = (c >> 3) + 32 * (p / 256); bh = xcd * (NBH / 8) + idx / HALFQ; a = idx % HALFQ; }
        else { bh = p / HALFQ; a = p % HALFQ; }
        const int b = bh / (NBH / 2), hd = bh % (NBH / 2);
        if (score_bound<DIFF>(Tn, b, hd) < 100.0f) { unit<DIFF, true>(lds, Tn, b, hd, NQ - 1 - a); unit<DIFF, true>(lds, Tn, b, hd, a); }
        else { unit<DIFF, false>(lds, Tn, b, hd, NQ - 1 - a); unit<DIFF, false>(lds, Tn, b, hd, a); }
    }
}
}

struct TrItem { const float* W; int srcN, src, K; bf16_t* WT; int dst_row, k0; const float* gain; };
DI void tr_load(const TrItem& t, f32x4 (&v)[8], int lane) {
    if (t.src < 0) return;
    const float* wp = t.W + (size_t)(t.k0 + (lane >> 3)) * t.srcN + t.src + (lane & 7) * 4;
#pragma unroll
    for (int i = 0; i < 8; ++i) v[i] = *(const f32x4*)(wp + (size_t)(8 * i) * t.srcN);
}
DI void tr_store(const TrItem& t, const f32x4 (&v)[8], LAS float* scr, int lane) {
    const int c = lane & 7, K = t.K;
    if (t.src < 0) {
#pragma unroll
        for (int j = 0; j < 4; ++j) { const int n = (lane >> 3) + 8 * j; *(u32x4*)(t.WT + (size_t)(t.dst_row + n) * K + t.k0 + 8 * c) = (u32x4){0u, 0u, 0u, 0u}; }
        return;
    }
    { const int kk = lane >> 3, c4 = (lane & 7) * 4;
#pragma unroll
      for (int i = 0; i < 8; ++i) { const float gn = t.gain ? t.gain[t.k0 + 8 * i + kk] : 1.0f; LAS float* sp = scr + (8 * i + kk) * 33 + c4;
          sp[0] = v[i][0] * gn; sp[1] = v[i][1] * gn; sp[2] = v[i][2] * gn; sp[3] = v[i][3] * gn; } }
    asm volatile("s_waitcnt lgkmcnt(0)" ::: "memory");
#pragma unroll
    for (int j = 0; j < 4; ++j) { const int n = (lane >> 3) + 8 * j; const LAS float* sp = scr + (8 * c) * 33 + n;
        u32x4 o; o.x = cvtpk(sp[0 * 33], sp[1 * 33]); o.y = cvtpk(sp[2 * 33], sp[3 * 33]); o.z = cvtpk(sp[4 * 33], sp[5 * 33]); o.w = cvtpk(sp[6 * 33], sp[7 * 33]);
        *(u32x4*)(t.WT + (size_t)(t.dst_row + n) * K + t.k0 + 8 * c) = o; }
    asm volatile("s_waitcnt lgkmcnt(0)" ::: "memory");
}

typedef const __attribute__((address_space(4))) Args* KArgs;
DI KArgs fresh_args() { KArgs p = (KArgs)__builtin_amdgcn_kernarg_segment_ptr(); asm volatile("" : "+s"(p)); return p; }
enum { SEG_IN = 0, SEG_UQ, SEG_UKV, SEG_MLA, SEG_DIFF, SEG_OUT, SEG_GU, SEG_DN, NSEG };

DI void convert_weights(KArgs a, LAS unsigned char* lds, int seg_lo, int seg_hi, int gw, int NGW);
DI void prologue(KArgs a, LAS unsigned char* lds) {
    unsigned char* ws = a->ws;
    int tid_ = threadIdx.x; asm volatile("" : "+v"(tid_));
    const int tid = tid_, lane = tid & 63, wave = __builtin_amdgcn_readfirstlane(tid >> 6);
    const int G = gridDim.x, gw = blockIdx.x * 8 + wave, NGW = G * 8, gt = blockIdx.x * 512 + tid, NGT = G * 512;
    { float* ssq = (float*)(ws + WS_SSQ); for (int i = gt; i < 3 * T + 1024; i += NGT) ssq[i] = 0.f; }
    { float* rc = (float*)(ws + WS_ROPE_C); float* rsn = (float*)(ws + WS_ROPE_S);
      for (int i = gt; i < SEQ * 32; i += NGT) { const int pos = i >> 5, f = i & 31;
          const float inv = (float)exp2(-(double)f * 0.4152410118609203);
          const float ang = (float)pos * inv;
          const double t = (double)ang * 0.15915494309189535;
          const float fr = (float)(t - rint(t));
          rc[i] = __builtin_amdgcn_cosf(fr); rsn[i] = __builtin_amdgcn_sinf(fr); } }
    { bf16_t* H = (bf16_t*)(ws + WS_H);
      for (int row = gw; row < T; row += 2 * NGW) {
          const int row1 = row + NGW; const bool two = row1 < T;
          const f32x4* xr0 = (const f32x4*)(a->x + (size_t)row * DM) + lane; const f32x4* xr1 = (const f32x4*)(a->x + (size_t)(two ? row1 : row) * DM) + lane;
          f32x4 v0[8], v1[8]; float s0 = 0.f, s1 = 0.f;
#pragma unroll
          for (int j = 0; j < 8; ++j) v0[j] = xr0[64 * j];
#pragma unroll
          for (int j = 0; j < 8; ++j) v1[j] = xr1[64 * j];
#pragma unroll
          for (int j = 0; j < 8; ++j) { s0 += dot4(v0[j]); s1 += dot4(v1[j]); }
          const float rs0 = __builtin_amdgcn_rsqf(wave_sum(s0, lane) * (1.0f / DM) + EPS), rs1 = __builtin_amdgcn_rsqf(wave_sum(s1, lane) * (1.0f / DM) + EPS);
          u32x2* o0 = (u32x2*)(H + (size_t)row * DM) + lane; u32x2* o1 = (u32x2*)(H + (size_t)row1 * DM) + lane;
#pragma unroll
          for (int j = 0; j < 8; ++j) { const f32x4 g = *((const f32x4*)a->attn_norm_g + lane + 64 * j); const f32x4 y0 = v0[j] * rs0 * g, y1 = v1[j] * rs1 * g;
              u32x2 pk; pk.x = cvtpk(y0[0], y0[1]); pk.y = cvtpk(y0[2], y0[3]); o0[64 * j] = pk;
              if (two) { u32x2 pk1; pk1.x = cvtpk(y1[0], y1[1]); pk1.y = cvtpk(y1[2], y1[3]); o1[64 * j] = pk1; } } } }
    convert_weights(a, lds, SEG_IN, SEG_IN + 1, gw, NGW);
}

DI void convert_weights(KArgs a, LAS unsigned char* lds, int seg_lo, int seg_hi, int gw, int NGW) {
    unsigned char* ws = a->ws;
    int tid_ = threadIdx.x; asm volatile("" : "+v"(tid_));
    const int lane = tid_ & 63, wave = __builtin_amdgcn_readfirstlane(tid_ >> 6);
    LAS float* scr = (LAS float*)(lds + wave * 16384);
    int base = 0;
#pragma unroll 1
    for (int seg = seg_lo; seg < seg_hi; ++seg) {
        int K, ngr;
        switch (seg) { case SEG_IN: K = 2048; ngr = N_IN_PAD / 32; break; case SEG_UQ: K = 768; ngr = 96; break; case SEG_UKV: K = 512; ngr = 128; break;
                       case SEG_GU: K = 2048; ngr = 352; break; case SEG_DN: K = D_FF; ngr = 64; break; default: K = 2048; ngr = 64; break; }
        const int nkb = K / 64, nitems = ngr * nkb;
        const int first = (int)(((long)gw - base % NGW + NGW) % NGW);
#define DECODE_ITEM(it_, T_) do { const int g = (it_) % ngr, k0 = ((it_) / ngr) * 64; \
            const float* W; int srcN, src; bf16_t* WT; const float* gain = nullptr; \
            switch (seg) { \
            case SEG_IN: { W = a->w_in; srcN = D_IN; WT = (bf16_t*)(ws + WS_WT_IN); const int n0 = g * 32; \
            if (n0 < 1280) src = n0; else if (n0 < 7424) src = n0 + 64; else if (n0 < 11520) src = n0 + 64; \
            else { const int j = n0 - 11520; src = (j == 0) ? 1280 : (j == 128 ? 1312 : -1); } } break; \
            case SEG_UQ: { W = a->w_uq; srcN = 3072; WT = (bf16_t*)(ws + WS_WT_UQ); gain = a->q_norm_g; \
            if (g < 64) src = (g >> 2) * 192 + (g & 3) * 32; \
            else { const int gp = g - 64, t = gp >> 3, j = gp & 7; src = (4 * t + (j & 3)) * 192 + 128 + (j >> 2) * 32; } } break; \
            case SEG_UKV: W = a->w_ukv; srcN = 4096; WT = (bf16_t*)(ws + WS_WT_UKV); gain = a->kv_norm_g; src = g * 32; break; \
            case SEG_MLA: W = a->w_mla_proj; srcN = 2048; WT = (bf16_t*)(ws + WS_WT_MLA); src = g * 32; break; \
            case SEG_DIFF: W = a->w_diff_proj; srcN = 2048; WT = (bf16_t*)(ws + WS_WT_DIFF); src = g * 32; break; \
            case SEG_OUT: W = a->w_out; srcN = 2048; WT = (bf16_t*)(ws + WS_WT_OUT); src = g * 32; break; \
            case SEG_GU: { const int t = g >> 3, j = g & 7; W = (j < 4) ? a->w_ffn_gate : a->w_ffn_up; srcN = D_FF; WT = (bf16_t*)(ws + WS_WT_GU); gain = a->ffn_norm_g; src = 128 * t + 32 * (j & 3); } break; \
            default: W = a->w_ffn_down; srcN = 2048; WT = (bf16_t*)(ws + WS_WT_DN); src = g * 32; break; \
            } \
            T_.W = W; T_.srcN = srcN; T_.src = src; T_.K = K; T_.WT = WT; T_.dst_row = g * 32; T_.k0 = k0; T_.gain = gain; } while (0)
#pragma unroll 1
        for (int it = first; it < nitems; it += 2 * NGW) {
            TrItem t0, t1; f32x4 v0[8], v1[8]; const bool two = (it + NGW < nitems);
            DECODE_ITEM(it, t0); tr_load(t0, v0, lane);
            if (two) { DECODE_ITEM(it + NGW, t1); tr_load(t1, v1, lane); }
            tr_store(t0, v0, scr, lane);
            if (two) tr_store(t1, v1, scr, lane);
        }
#undef DECODE_ITEM
        base += nitems;
    }
}


#define XB_TMO      128
#define XB_XCNT(j)  (256  + 64 * (j))
#define XB_XSUB(j)  (1280 + 64 * (j))
#define XB_XGEN(j)  (2304 + 64 * (j))
#define XB_TOP      3328
#define XB_TOPGEN   3392
#define XCD_BAR_WORDS 3456
#define XB_SPIN_CAP (1u << 18)
DI unsigned xb_ld(unsigned* p)              { return __hip_atomic_load(p, __ATOMIC_RELAXED, __HIP_MEMORY_SCOPE_AGENT); }
DI unsigned xb_add(unsigned* p, unsigned v) { return __hip_atomic_fetch_add(p, v, __ATOMIC_RELAXED, __HIP_MEMORY_SCOPE_AGENT); }
DI unsigned xb_xcc_id() { return (unsigned)__builtin_amdgcn_s_getreg((3 << 11) | 20) & 0xFu; }
#define XB_SPIN(cond, bar) do { unsigned _sp = 0; while (cond) { __builtin_amdgcn_s_sleep(1); \
    if ((++_sp & 255u) == 0u) { if (xb_ld(&(bar)[XB_TMO])) break; if (_sp > XB_SPIN_CAP) { atomicAdd(&(bar)[XB_TMO], 1u); break; } } } } while (0)
struct XcdBarrier { unsigned* bar; unsigned x; volatile LAS unsigned* st; };
DI XcdBarrier xcd_barrier_post(unsigned* bar, volatile LAS unsigned* st) {
    XcdBarrier b; b.bar = bar; b.x = xb_xcc_id(); b.st = st;
    if (threadIdx.x == 0) (void)xb_add(&bar[XB_XCNT(b.x)], 1u);
    return b;
}
DI void xcd_barrier_complete(unsigned* bar, unsigned x, unsigned& nloc, unsigned& nx) {
    const unsigned G = gridDim.x * gridDim.y * gridDim.z;
    unsigned sum, cnt, mine, sp = 0u;
    for (;;) {
        sum = 0u; cnt = 0u; mine = 0u;
#pragma unroll
        for (unsigned j = 0; j < 16; ++j) { const unsigned c = xb_ld(&bar[XB_XCNT(j)]); sum += c; cnt += (c > 0u) ? 1u : 0u; mine = (j == x) ? c : mine; }
        if (sum == G) break;
        __builtin_amdgcn_s_sleep(1);
        if ((++sp & 255u) == 0u) { if (xb_ld(&bar[XB_TMO])) break; if (sp > XB_SPIN_CAP) { atomicAdd(&bar[XB_TMO], 1u); break; } }
    }
    nloc = mine > 0u ? mine : 1u; nx = cnt > 0u ? cnt : 1u;
}
DI void xcd_barrier(const XcdBarrier& b) {
    asm volatile("s_waitcnt vmcnt(0)" ::: "memory");
    __syncthreads();
    if (threadIdx.x == 0) {
        unsigned* bar = b.bar;
        __builtin_amdgcn_s_waitcnt(0);
        unsigned nloc = b.st[0], nx = b.st[1];
        if (nloc == 0u) { xcd_barrier_complete(bar, b.x, nloc, nx); b.st[0] = nloc; b.st[1] = nx; }
        const unsigned old = xb_add(&bar[XB_XSUB(b.x)], 1u);
        const unsigned gen = old / nloc;
        if (old + 1u == (gen + 1u) * nloc) {
            __builtin_amdgcn_fence(__ATOMIC_RELEASE, "agent");
            asm volatile("s_waitcnt vmcnt(0)" ::: "memory");
            const unsigned og = xb_add(&bar[XB_TOP], 1u);
            const unsigned tg = og / nx;
            if (og + 1u == (tg + 1u) * nx) xb_add(&bar[XB_TOPGEN], 1u);
            else XB_SPIN(xb_ld(&bar[XB_TOPGEN]) == tg, bar);
            __builtin_amdgcn_fence(__ATOMIC_ACQUIRE, "agent");
            xb_add(&bar[XB_XGEN(b.x)], 1u);
            asm volatile("s_waitcnt vmcnt(0)" ::: "memory");
        } else {
            XB_SPIN(xb_ld(&bar[XB_XGEN(b.x)]) == gen, bar);
            __builtin_amdgcn_fence(__ATOMIC_ACQUIRE, "agent");
            asm volatile("s_waitcnt vmcnt(0)" ::: "memory");
        }
    }
    __syncthreads();
}

__global__ void __launch_bounds__(512, 2) fwd_kernel(Args a_unused) {
    extern __shared__ __attribute__((aligned(16))) unsigned char lds_raw[];
    LAS unsigned char* lds = (LAS unsigned char*)lds_raw;
    cg::grid_group grid = cg::this_grid();
    volatile LAS unsigned* xst = (volatile LAS unsigned*)(lds + LDS_BYTES - 32);
    if (threadIdx.x == 0) { xst[0] = 0u; xst[1] = 0u; }
    unsigned char* ws = fresh_args()->ws; float* const outp = fresh_args()->out;
    const int G = gridDim.x, cidx = blockIdx.x;
    bf16_t* WT_IN = (bf16_t*)(ws + WS_WT_IN); bf16_t* WT_UQ = (bf16_t*)(ws + WS_WT_UQ); bf16_t* WT_UKV = (bf16_t*)(ws + WS_WT_UKV); bf16_t* WT_MLA = (bf16_t*)(ws + WS_WT_MLA);
    bf16_t* WT_DIFF = (bf16_t*)(ws + WS_WT_DIFF); bf16_t* WT_OUT = (bf16_t*)(ws + WS_WT_OUT); bf16_t* WT_GU = (bf16_t*)(ws + WS_WT_GU); bf16_t* WT_DN = (bf16_t*)(ws + WS_WT_DN);
    float* RC = (float*)(ws + WS_ROPE_C); float* RS = (float*)(ws + WS_ROPE_S);
    float* SSQ_Q = (float*)(ws + WS_SSQ); float* SSQ_KV = SSQ_Q + T; float* SSQ_F = SSQ_KV + T;
    unsigned* CTL = (unsigned*)(ws + WS_CTL);
    bf16_t* KR = (bf16_t*)(ws + WS_KR); bf16_t* H = (bf16_t*)(ws + WS_H); bf16_t* YDIFF = H;
    bf16_t* DQKV = (bf16_t*)(ws + WS_R1); bf16_t* Qb = (bf16_t*)(ws + WS_R1); bf16_t* KVb = Qb + (size_t)T * 3072;
    bf16_t* MERGED = (bf16_t*)(ws + WS_R1 + (size_t)T * 2048 * 4); bf16_t* Ub = (bf16_t*)(ws + WS_R1);
    bf16_t* CQKV = (bf16_t*)(ws + WS_R2); bf16_t* YMLA = (bf16_t*)(ws + WS_R2); bf16_t* X1B = (bf16_t*)(ws + WS_R2);
    bf16_t* GATES = (bf16_t*)outp;

    { unsigned* bw = (unsigned*)(ws + WS_BAR); for (int i = blockIdx.x * 512 + threadIdx.x; i < 4096; i += G * 512) bw[i] = 0u; }
    grid.sync();
    const XcdBarrier xb = xcd_barrier_post((unsigned*)(ws + WS_BAR), xst);
    prologue(fresh_args(), lds);
    xcd_barrier(xb);
    { pg8::Gemm g{H, WT_IN, T, N_IN_PAD, 2048, 2048}; pg8::StaticOrder S; S.init(T, N_IN_PAD, G, cidx);
      EpiIn E{CQKV, DQKV, GATES, KR, SSQ_Q, SSQ_KV, fresh_args()->b_gate, RC, RS, CTL};
      pg8::gemm_phase(lds, g, S, E);
      const int rem = (64 * (N_IN_PAD / 256)) % G; int tw_ = threadIdx.x; asm volatile("" : "+v"(tw_)); const int wv = __builtin_amdgcn_readfirstlane(tw_ >> 6);
      if (rem == 0) convert_weights(fresh_args(), lds, SEG_UQ, NSEG, cidx * 8 + wv, G * 8);
      else if (cidx >= rem) convert_weights(fresh_args(), lds, SEG_UQ, NSEG, (cidx - rem) * 8 + wv, (G - rem) * 8); }
    xcd_barrier(xb);
    { int tl_ = threadIdx.x; asm volatile("" : "+v"(tl_)); const int ln = tl_ & 63;
      KArgs ka = fresh_args(); const float* lq1 = ka->lq1; const float* lk1 = ka->lk1; const float* lq2 = ka->lq2; const float* lk2 = ka->lk2;
      float s1 = lq1[ln] * lk1[ln] + lq1[64 + ln] * lk1[64 + ln];
      float s2 = lq2[ln] * lk2[ln] + lq2[64 + ln] * lk2[64 + ln];
      const float lam = __expf(wave_sum(s1, ln)) - __expf(wave_sum(s2, ln)) + LAMBDA_INIT;
      att::Tensors Tn{DQKV, 6144, DQKV + 2048, 6144, DQKV + 4096, nullptr, YDIFF, ka->diff_norm_g, lam, CTL, CTL + 768};
      att::phase<true>(lds, Tn); }
    xcd_barrier(xb);
    { pg8::Gemm g{CQKV, WT_UQ, T, 3072, 768, 1280}; pg8::StaticOrder S; S.init(T, 3072, G, cidx);
      EpiUQ E{Qb, SSQ_Q, RC, RS, CTL};
      pg8::gemm_phase(lds, g, S, E); }
    { pg8::Gemm g{CQKV + 768, WT_UKV, T, 4096, 512, 1280}; pg8::StaticOrder S; S.init(T, 4096, G, cidx);
      EpiUKV E{KVb, SSQ_KV, CTL};
      pg8::gemm_phase(lds, g, S, E); }
    xcd_barrier(xb);
    { att::Tensors Tn{Qb, 3072, KVb, 4096, KVb + 128, KR, YMLA, nullptr, 0.f, CTL, nullptr};
      att::phase<false>(lds, Tn); }
    xcd_barrier(xb);
    { pg8::Gemm g{YMLA, WT_MLA, T, 2048, 2048, 2048}; pg8::StaticOrder S; S.init(T, 2048, G, cidx);
      EpiMixA E{MERGED, GATES};
      pg8::gemm_phase(lds, g, S, E); }
    { pg8::Gemm g{YDIFF, WT_DIFF, T, 2048, 2048, 2048}; pg8::StaticOrder S; S.init(T, 2048, G, cidx);
      EpiMixB E{GATES, MERGED};
      pg8::gemm_phase(lds, g, S, E); }
    xcd_barrier(xb);
    { pg8::Gemm g{MERGED, WT_OUT, T, 2048, 2048, 2048}; pg8::StaticOrder S; S.init(T, 2048, G, cidx);
      EpiRes<true> E{fresh_args()->x, outp, X1B, SSQ_F};
      pg8::gemm_phase(lds, g, S, E); }
    xcd_barrier(xb);
    { pg8::Gemm g{X1B, WT_GU, T, 2 * D_FF, 2048, 2048}; pg8::StaticOrder S; S.init(T, 2 * D_FF, G, cidx);
      EpiGU E{Ub, SSQ_F};
      pg8::gemm_phase(lds, g, S, E); }
    xcd_barrier(xb);
    { pg8::Gemm g{Ub, WT_DN, T, 2048, D_FF, D_FF}; pg8::StaticOrder S; S.init(T, 2048, G, cidx);
      EpiRes<false> E{outp, outp, nullptr, nullptr};
      pg8::gemm_phase(lds, g, S, E); }
    xcd_barrier(xb);
    { const float* fng = fresh_args()->final_norm_g; int tf_ = threadIdx.x; asm volatile("" : "+v"(tf_)); const int lane = tf_ & 63, wave = tf_ >> 6, gw = blockIdx.x * 8 + wave, NGW = G * 8;
      for (int row = gw; row < T; row += 2 * NGW) {
          const int row1 = row + NGW; const bool two = row1 < T;
          f32x4* xr0 = (f32x4*)(outp + (size_t)row * DM) + lane; f32x4* xr1 = (f32x4*)(outp + (size_t)(two ? row1 : row) * DM) + lane;
          f32x4 v0[8], v1[8]; float s0 = 0.f, s1 = 0.f;
#pragma unroll
          for (int j = 0; j < 8; ++j) v0[j] = xr0[64 * j];
#pragma unroll
          for (int j = 0; j < 8; ++j) v1[j] = xr1[64 * j];
#pragma unroll
          for (int j = 0; j < 8; ++j) { s0 += dot4(v0[j]); s1 += dot4(v1[j]); }
          const float rs0 = __builtin_amdgcn_rsqf(wave_sum(s0, lane) * (1.0f / DM) + EPS), rs1 = __builtin_amdgcn_rsqf(wave_sum(s1, lane) * (1.0f / DM) + EPS);
#pragma unroll
          for (int j = 0; j < 8; ++j) { const f32x4 g = *((const f32x4*)fng + lane + 64 * j); __builtin_nontemporal_store(v0[j] * rs0 * g, &xr0[64 * j]); if (two) __builtin_nontemporal_store(v1[j] * rs1 * g, &xr1[64 * j]); } } }
}

extern "C" void kernel_launch(void* const* d_in, const int* in_sizes, int n_in, void* d_out, int out_size, void* d_ws, size_t ws_size, hipStream_t stream) {
    static int grid = 0;
    if (grid == 0) {
        if (n_in != 21 || in_sizes[0] != T * DM || out_size != T * DM || ws_size < WS_END) {
            fprintf(stderr, "kernel_launch: unexpected shapes (n_in %d, in0 %d, out %d, ws %zu, need %zu)\n", n_in, n_in > 0 ? in_sizes[0] : -1, out_size, ws_size, (size_t)WS_END); grid = -1; return; }
        int dev = 0, cus = 0, per_cu = 0;
        if (hipGetDevice(&dev) != hipSuccess || hipDeviceGetAttribute(&cus, hipDeviceAttributeMultiprocessorCount, dev) != hipSuccess) { grid = -1; return; }
        if (hipFuncSetAttribute((const void*)fwd_kernel, hipFuncAttributeMaxDynamicSharedMemorySize, LDS_BYTES) != hipSuccess) { fprintf(stderr, "kernel_launch: hipFuncSetAttribute failed\n"); grid = -1; return; }
        if (hipOccupancyMaxActiveBlocksPerMultiprocessor(&per_cu, (const void*)fwd_kernel, 512, LDS_BYTES) != hipSuccess || per_cu < 1) { fprintf(stderr, "kernel_launch: occupancy query gave %d\n", per_cu); per_cu = 1; }
        (void)hipGetLastError();
        grid = cus * per_cu;
    }
    if (grid < 0) return;
    Args a{};
    const float** ap = (const float**)&a;
    for (int i = 0; i < 21; ++i) ap[i] = (const float*)d_in[i];
    a.out = (float*)d_out; a.ws = (unsigned char*)d_ws;
    void* args[] = {&a};
    hipError_t e = hipLaunchCooperativeKernel((const void*)fwd_kernel, dim3(grid), dim3(512), args, LDS_BYTES, stream);
    if (e != hipSuccess) fprintf(stderr, "cooperative launch failed: %s (grid %d)\n", hipGetErrorString(e), grid);
}
```

```cpp
#include <hip/hip_runtime.h>
#include <hip/hip_cooperative_groups.h>
#include <cstdio>
#include <cstdint>
namespace cg = cooperative_groups;

#define LAS __attribute__((address_space(3)))
#define DI __device__ __forceinline__
typedef unsigned short bf16_t;
typedef short bf16x8 __attribute__((ext_vector_type(8)));
typedef short s16x4 __attribute__((ext_vector_type(4)));
typedef float f32x4 __attribute__((ext_vector_type(4)));
typedef float f32x16 __attribute__((ext_vector_type(16)));
typedef unsigned u32x4 __attribute__((ext_vector_type(4)));
typedef unsigned u32x2 __attribute__((ext_vector_type(2)));
typedef float f32x2_t __attribute__((ext_vector_type(2)));
typedef __bf16 bf16x2_t __attribute__((ext_vector_type(2)));

constexpr int SEQ = 8192, BATCH = 2, T = BATCH * SEQ, DM = 2048;
constexpr int D_IN = 11584, D_FF = 5632;
constexpr int N_IN_PAD = 11776;
constexpr float EPS = 1e-6f;
constexpr float LOG2E = 1.4426950408889634f;
constexpr float QSCALE_MLA = 0.10411754627697264f;
constexpr float QSCALE_DIFF = 0.12751743082459868f;
constexpr float LAMBDA_INIT = 0.2f;

constexpr size_t SZ_WT_IN = (size_t)N_IN_PAD * 2048 * 2, SZ_WT_UQ = (size_t)3072 * 768 * 2, SZ_WT_UKV = (size_t)4096 * 512 * 2, SZ_WT_SQ = (size_t)2048 * 2048 * 2,
                 SZ_WT_GU = (size_t)2 * D_FF * 2048 * 2, SZ_WT_DN = (size_t)2048 * D_FF * 2;
constexpr size_t WS_WT_IN = 0, WS_WT_UQ = WS_WT_IN + SZ_WT_IN, WS_WT_UKV = WS_WT_UQ + SZ_WT_UQ, WS_WT_MLA = WS_WT_UKV + SZ_WT_UKV, WS_WT_DIFF = WS_WT_MLA + SZ_WT_SQ,
                 WS_WT_OUT = WS_WT_DIFF + SZ_WT_SQ, WS_WT_GU = WS_WT_OUT + SZ_WT_SQ, WS_WT_DN = WS_WT_GU + SZ_WT_GU, WS_ROPE_C = WS_WT_DN + SZ_WT_DN,
                 WS_ROPE_S = WS_ROPE_C + (size_t)SEQ * 32 * 4, WS_SSQ = WS_ROPE_S + (size_t)SEQ * 32 * 4, WS_CTL = WS_SSQ + (size_t)3 * T * 4, WS_BAR = WS_CTL + 4096, WS_KR = WS_BAR + 16384, WS_H = WS_KR + (size_t)T * 64 * 2,
                 WS_R1 = WS_H + (size_t)T * 2048 * 2, WS_R2 = WS_R1 + (size_t)T * (3072 + 4096) * 2, WS_END = WS_R2 + (size_t)T * 2048 * 2;
static_assert(WS_END <= (size_t)512 * 1024 * 1024, "workspace map exceeds 512 MiB");
static_assert(WS_WT_UQ % 256 == 0 && WS_ROPE_C % 256 == 0 && WS_KR % 256 == 0 && WS_H % 256 == 0 && WS_R1 % 256 == 0 && WS_R2 % 256 == 0, "alignment");

constexpr int LDS_BYTES = 147456;

struct Args {
    const float* x; const float* attn_norm_g; const float* w_in; const float* b_gate; const float* q_norm_g; const float* w_uq; const float* kv_norm_g; const float* w_ukv;
    const float* lq1; const float* lk1; const float* lq2; const float* lk2; const float* diff_norm_g; const float* w_mla_proj; const float* w_diff_proj; const float* w_out;
    const float* ffn_norm_g; const float* w_ffn_gate; const float* w_ffn_up; const float* w_ffn_down; const float* final_norm_g;
    float* out; unsigned char* ws;
};

DI unsigned cvtpk(float lo, float hi) { f32x2_t v = {lo, hi}; bf16x2_t b = __builtin_convertvector(v, bf16x2_t); return __builtin_bit_cast(unsigned, b); }
DI float bf_lo(unsigned u) { return __builtin_bit_cast(float, u << 16); }
DI float bf_hi(unsigned u) { return __builtin_bit_cast(float, u & 0xffff0000u); }
template <int MASK> DI float shx(float v, int lane) { return __builtin_bit_cast(float, __builtin_amdgcn_ds_bpermute((lane ^ MASK) << 2, __builtin_bit_cast(int, v))); }
DI float wave_sum(float v, int lane) {
    v += shx<1>(v, lane); v += shx<2>(v, lane); v += shx<4>(v, lane); v += shx<8>(v, lane); v += shx<16>(v, lane); v += shx<32>(v, lane);
    return v;
}
DI float fast_exp2(float x) { return __builtin_amdgcn_exp2f(x); }
DI float fast_rcp(float x) { return __builtin_amdgcn_rcpf(x); }
DI float sigmoidf_(float v) { return fast_rcp(1.0f + fast_exp2(-v * LOG2E)); }
DI void atomic_addf(float* p, float v) { (void)__hip_atomic_fetch_add(p, v, __ATOMIC_RELAXED, __HIP_MEMORY_SCOPE_AGENT); }

namespace pg8 {
constexpr int BM = 256, BK = 64, HALF = 128, HTB = HALF * BK * 2, STAGE_BYTES = 8 * HTB, NXCD = 8, WGM = 4;
DI int lds_byte(int r, int c) { const int st = (r >> 4) * 2 + (c >> 5), rr = r & 15, cc = c & 31, ob = rr * 64 + cc * 2; return st * 1024 + (ob ^ (((ob >> 9) & 1) << 5)); }
DI void stage_rc(int b, int& R, int& C) { const int st = b / 1024, sb = b % 1024, swz = sb ^ (((sb >> 9) & 1) << 5); R = (st >> 1) * 16 + swz / 64; C = (st & 1) * 32 + (swz % 64) / 2; }
DI int perm32(int rho) { const int n = rho >> 4, i = rho & 15; return 8 * (i >> 2) + 4 * n + (i & 3); }

struct Unit { int pm, pn; };
struct Gemm { const bf16_t* A; const bf16_t* Bt; int M, N, K, lda; };

struct StaticOrder {
    int nM, nN, nwg, G, c;
    DI void init(int M, int N, int G_, int c_) { nM = M / BM; nN = N / BM; nwg = nM * nN; G = G_; c = c_; }
    DI bool next(int i, Unit& u) const {
        const long L = (long)i * G + c; if (L >= nwg) return false;
        int wgid = (int)L; { const int q = nwg / NXCD, r = nwg % NXCD, xcd = wgid % NXCD, off = wgid / NXCD; wgid = (xcd < r ? xcd * (q + 1) : r * (q + 1) + (xcd - r) * q) + off; }
        const int nig = WGM * nN, gid = wgid / nig, fm = gid * WGM, gsz = (nM - fm) < WGM ? (nM - fm) : WGM;
        u.pm = fm + ((wgid % nig) % gsz); u.pn = (wgid % nig) / gsz; return true;
    }
    DI void a_ready(const Unit&) const {}
    DI void done(const Unit&) const {}
};

template <class Epi, class Sched>
DI void gemm_phase(LAS unsigned char* lds, const Gemm g, const Sched& S, const Epi& E) {
    int tid_ = threadIdx.x; asm volatile("" : "+v"(tid_));
    const int tid = tid_, wid = __builtin_amdgcn_readfirstlane(tid >> 6), lane = tid & 63, wr = wid >> 2, wc = wid & 3, fr = lane & 15, fq = lane >> 4;
    const int K = g.K, nt = K / BK, lda = g.lda;
    unsigned voffA[2], voffB[2];
#pragma unroll
    for (int i = 0; i < 2; ++i) { int R, C; stage_rc(tid * 16 + i * 8192, R, C); const int Rb = (R & ~31) + perm32(R & 31);
        voffA[i] = (unsigned)(R * lda + C) * 2u; voffB[i] = (unsigned)(Rb * K + C) * 2u; }
    const size_t kstep = (size_t)(BK * 2);
    const size_t hstepA = (size_t)HALF * lda * 2, hstepB = (size_t)HALF * K * 2;
    const size_t tstepA = 2 * hstepA, tstepB = 2 * hstepB;
    const unsigned ldsw = (unsigned)wid * 1024u;
    const int aoff = lds_byte(wr * 64 + fr, fq * 8), boff = lds_byte(wc * 32 + fr, fq * 8);
#define PG8_SA(b, h) (((b) * 2 + (h)) * HTB)
#define PG8_SB(b, h) ((4 + (b) * 2 + (h)) * HTB)
#define PG8_STAGE(bufoff, gbase, voff) do { _Pragma("unroll") for (int _i = 0; _i < 2; ++_i) \
        __builtin_amdgcn_global_load_lds((const unsigned*)((const char*)(gbase) + (voff)[_i]), (LAS unsigned*)(lds + (bufoff) + ldsw + _i * 8192), 16, 0, 0); } while (0)
#define PG8_LDA(dst, b, h) do { _Pragma("unroll") for (int m = 0; m < 4; ++m) _Pragma("unroll") for (int k = 0; k < 2; ++k) dst[m][k] = *(const LAS bf16x8*)(lds + PG8_SA(b, h) + aoff + m * 2048 + k * 1024); } while (0)
#define PG8_LDB(dst, b, h) do { _Pragma("unroll") for (int n = 0; n < 2; ++n) _Pragma("unroll") for (int k = 0; k < 2; ++k) dst[n][k] = *(const LAS bf16x8*)(lds + PG8_SB(b, h) + boff + n * 2048 + k * 1024); } while (0)
#define PG8_MMA(ai, bj, At, Bt) do { __builtin_amdgcn_s_setprio(1); _Pragma("unroll") for (int m = 0; m < 4; ++m) _Pragma("unroll") for (int n = 0; n < 2; ++n) _Pragma("unroll") for (int k = 0; k < 2; ++k) \
        acc[ai][bj][m][n] = __builtin_amdgcn_mfma_f32_16x16x32_bf16(Bt[n][k], At[m][k], acc[ai][bj][m][n], 0, 0, 0); __builtin_amdgcn_s_setprio(0); } while (0)
#define PG8_WAIT_V(n) asm volatile("s_waitcnt vmcnt(" #n ")" ::: "memory")
#define PG8_WAIT_L(n) asm volatile("s_waitcnt lgkmcnt(" #n ")" ::: "memory")
#define PG8_BAR __builtin_amdgcn_s_barrier()
#define PG8_SCHED __builtin_amdgcn_sched_barrier(0)
    Unit cur, nxt; int ui = 0;
    if (!S.next(0, cur)) return;
    f32x4 acc[2][2][4][2];
#pragma unroll
    for (int a = 0; a < 2; ++a)
#pragma unroll
        for (int b = 0; b < 2; ++b)
#pragma unroll
            for (int m = 0; m < 4; ++m)
#pragma unroll
                for (int n = 0; n < 2; ++n) acc[a][b][m][n] = (f32x4){0.f, 0.f, 0.f, 0.f};
    bf16x8 At[4][2], B0[2][2], B1[2][2];
    const char* cA = (const char*)g.A + (size_t)cur.pm * tstepA; const char* cB = (const char*)g.Bt + (size_t)cur.pn * tstepB;
    PG8_STAGE(PG8_SB(0, 0), cB, voffB); PG8_STAGE(PG8_SB(0, 1), cB + hstepB, voffB); PG8_STAGE(PG8_SA(0, 0), cA, voffA); PG8_STAGE(PG8_SA(0, 1), cA + hstepA, voffA);
    if (wr == 1) PG8_BAR;
    PG8_WAIT_V(2); PG8_BAR;
    PG8_STAGE(PG8_SB(1, 0), cB + kstep, voffB); PG8_STAGE(PG8_SA(1, 0), cA + kstep, voffA); PG8_STAGE(PG8_SB(1, 1), cB + hstepB + kstep, voffB);
    PG8_WAIT_V(6); PG8_BAR;
    for (;;) {
        const bool has_next = S.next(ui + 1, nxt);
        const char* nA = has_next ? (const char*)g.A + (size_t)nxt.pm * tstepA : cA; const char* nB = has_next ? (const char*)g.Bt + (size_t)nxt.pn * tstepB : cB;
        for (int t = 0; t < nt; t += 2) {
            const bool last = (t == nt - 2);
            const char* a1 = cA + (size_t)(t + 1) * kstep;
            const char* a2 = last ? nA : cA + (size_t)(t + 2) * kstep; const char* b2 = last ? nB : cB + (size_t)(t + 2) * kstep;
            const char* a3 = a2 + kstep; const char* b3 = b2 + kstep;
            PG8_LDB(B0, 0, 0); PG8_LDB(B1, 0, 1); PG8_SCHED; PG8_LDA(At, 0, 0); PG8_STAGE(PG8_SA(1, 1), a1 + hstepA, voffA);
            PG8_WAIT_V(8); PG8_WAIT_L(0); PG8_BAR; PG8_MMA(0, 0, At, B0); PG8_MMA(0, 1, At, B1); PG8_BAR; PG8_SCHED;
            PG8_LDA(At, 0, 1); PG8_STAGE(PG8_SB(0, 0), b2, voffB); PG8_STAGE(PG8_SB(0, 1), b2 + hstepB, voffB); PG8_STAGE(PG8_SA(0, 0), a2, voffA);
            PG8_WAIT_V(8); PG8_WAIT_L(0); PG8_BAR; PG8_MMA(1, 0, At, B0); PG8_MMA(1, 1, At, B1); PG8_BAR; PG8_SCHED;
            PG8_LDB(B0, 1, 0); PG8_LDB(B1, 1, 1); PG8_SCHED; PG8_LDA(At, 1, 0); PG8_STAGE(PG8_SA(0, 1), a2 + hstepA, voffA);
            PG8_WAIT_V(8); PG8_WAIT_L(0); PG8_BAR; PG8_MMA(0, 0, At, B0); PG8_MMA(0, 1, At, B1); PG8_BAR; PG8_SCHED;
            PG8_LDA(At, 1, 1); PG8_STAGE(PG8_SB(1, 0), b3, voffB); PG8_STAGE(PG8_SB(1, 1), b3 + hstepB, voffB); PG8_STAGE(PG8_SA(1, 0), a3, voffA);
            PG8_WAIT_V(8); PG8_WAIT_L(0); PG8_BAR; PG8_MMA(1, 0, At, B0); PG8_MMA(1, 1, At, B1); PG8_BAR; PG8_SCHED;
        }
        if (wr == 0) PG8_BAR;
        E(acc, cur, wr, wc, fr, fq);
        if (!has_next) break;
#pragma unroll
        for (int a = 0; a < 2; ++a)
#pragma unroll
            for (int b = 0; b < 2; ++b)
#pragma unroll
                for (int m = 0; m < 4; ++m)
#pragma unroll
                    for (int n = 0; n < 2; ++n) acc[a][b][m][n] = (f32x4){0.f, 0.f, 0.f, 0.f};
        cur = nxt; cA = nA; cB = nB; ++ui;
        if (wr == 1) PG8_BAR;
    }
    PG8_WAIT_V(0);
    PG8_BAR;
#undef PG8_SA
#undef PG8_SB
#undef PG8_STAGE
#undef PG8_LDA
#undef PG8_LDB
#undef PG8_MMA
#undef PG8_WAIT_V
#undef PG8_WAIT_L
#undef PG8_BAR
#undef PG8_SCHED
}
}

using pg8::Unit;
typedef const f32x4 (&AccRef)[2][2][4][2];

DI void store8_bf16(bf16_t* p, f32x4 v0, f32x4 v1) {
    u32x4 w; w.x = cvtpk(v0[0], v0[1]); w.y = cvtpk(v0[2], v0[3]); w.z = cvtpk(v1[0], v1[1]); w.w = cvtpk(v1[2], v1[3]);
    *(u32x4*)p = w;
}
DI void load8_bf16(const bf16_t* p, f32x4& v0, f32x4& v1) {
    const u32x4 w = *(const u32x4*)p;
    v0 = (f32x4){bf_lo(w.x), bf_hi(w.x), bf_lo(w.y), bf_hi(w.y)}; v1 = (f32x4){bf_lo(w.z), bf_hi(w.z), bf_lo(w.w), bf_hi(w.w)};
}
DI float dot4(f32x4 v) { return (v[0] * v[0] + v[1] * v[1]) + (v[2] * v[2] + v[3] * v[3]); }

#define EPI_HDR static constexpr bool PERM = true, AFTER_DRAIN = false;
DI void wave16_atomic_max(unsigned* p, float mv, int fr, int fq) {
    const int ln = fr | (fq << 4);
    mv = __builtin_fmaxf(mv, shx<1>(mv, ln)); mv = __builtin_fmaxf(mv, shx<2>(mv, ln)); mv = __builtin_fmaxf(mv, shx<4>(mv, ln)); mv = __builtin_fmaxf(mv, shx<8>(mv, ln));
    if (fr == 0 && fq == 0) (void)__hip_atomic_fetch_max(p, __builtin_bit_cast(unsigned, mv), __ATOMIC_RELAXED, __HIP_MEMORY_SCOPE_AGENT);
}
constexpr int CW_QCTR = 256, CW_NQ = 320, CW_NK = 512, CW_NKR = 704;
#define FOR_ROWS _Pragma("unroll") for (int ai = 0; ai < 2; ++ai) _Pragma("unroll") for (int m = 0; m < 4; ++m)
#define FOR_BJ _Pragma("unroll") for (int bj = 0; bj < 2; ++bj)

struct EpiIn { EPI_HDR
    bf16_t* cqkv; bf16_t* dqkv; bf16_t* gates; bf16_t* kr; float* ssq_q; float* ssq_kv; const float* b_gate; const float* rcos; const float* rsin; unsigned* nrm;
    DI void operator()(AccRef acc, const Unit& u, int wr, int wc, int fr, int fq) const {
        const int pn = u.pn, row0 = u.pm * 256 + wr * 64 + fr, c8 = wc * 32 + 8 * fq;
        if (pn < 5) {
            float* ssq = pn < 3 ? ssq_q : ssq_kv;
            FOR_ROWS { const int row = row0 + ai * 128 + m * 16; float s = 0.f;
                FOR_BJ { const f32x4 v0 = acc[ai][bj][m][0], v1 = acc[ai][bj][m][1]; s += dot4(v0) + dot4(v1);
                    store8_bf16(cqkv + (size_t)row * 1280 + pn * 256 + bj * 128 + c8, v0, v1); }
                s += shx<16>(s, fr | (fq << 4)); s += shx<32>(s, fr | (fq << 4));
                if (fq == 0) atomic_addf(ssq + row, s); }
        } else if (pn < 21) {
            const float sc = pn < 13 ? QSCALE_DIFF : 1.0f;
            float mxp[2] = {0.f, 0.f};
            FOR_ROWS { const int row = row0 + ai * 128 + m * 16;
                FOR_BJ { const f32x4 v0 = acc[ai][bj][m][0] * sc, v1 = acc[ai][bj][m][1] * sc; float s = dot4(v0) + dot4(v1);
                    s += shx<16>(s, fr | (fq << 4)); s += shx<32>(s, fr | (fq << 4)); mxp[bj] = __builtin_fmaxf(mxp[bj], s);
                    store8_bf16(dqkv + (size_t)row * 6144 + (pn - 5) * 256 + bj * 128 + c8, v0, v1); } }
            const int sel = (pn - 5) >> 3, head = (pn - 5) & 7, bb = u.pm >> 5;
            FOR_BJ { float mv = mxp[bj]; mv = __builtin_fmaxf(mv, shx<1>(mv, fr | (fq << 4))); mv = __builtin_fmaxf(mv, shx<2>(mv, fr | (fq << 4))); mv = __builtin_fmaxf(mv, shx<4>(mv, fr | (fq << 4))); mv = __builtin_fmaxf(mv, shx<8>(mv, fr | (fq << 4)));
                if (fr == 0 && fq == 0) (void)__hip_atomic_fetch_max(nrm + ((((bb * 8 + head) * 2 + bj) * 2 + sel) * 4 + wc), __builtin_bit_cast(unsigned, mv), __ATOMIC_RELAXED, __HIP_MEMORY_SCOPE_AGENT); }
        } else if (pn < 29) {
            FOR_ROWS { const int row = row0 + ai * 128 + m * 16;
                FOR_BJ store8_bf16(dqkv + (size_t)row * 6144 + (pn - 5) * 256 + bj * 128 + c8, acc[ai][bj][m][0], acc[ai][bj][m][1]); }
        } else if (pn < 45) {
            f32x4 b0[2], b1[2];
            FOR_BJ { const float* bp = b_gate + (pn - 29) * 256 + bj * 128 + c8; b0[bj] = *(const f32x4*)bp; b1[bj] = *(const f32x4*)(bp + 4); }
            FOR_ROWS { const int row = row0 + ai * 128 + m * 16;
                FOR_BJ { f32x4 v0 = acc[ai][bj][m][0] + b0[bj], v1 = acc[ai][bj][m][1] + b1[bj];
#pragma unroll
                    for (int e = 0; e < 4; ++e) { v0[e] = sigmoidf_(v0[e]); v1[e] = sigmoidf_(v1[e]); }
                    store8_bf16(gates + (size_t)row * 4096 + (pn - 29) * 256 + bj * 128 + c8, v0, v1); } }
        } else {
            if (wc == 0) {
                float mxr = 0.f;
                FOR_ROWS { const int row = row0 + ai * 128 + m * 16, pos = row & (SEQ - 1);
                    f32x4 o1[2], o2[2]; float sq = 0.f;
#pragma unroll
                    for (int n = 0; n < 2; ++n) { const f32x4 c = *(const f32x4*)(rcos + pos * 32 + 8 * fq + 4 * n), s = *(const f32x4*)(rsin + pos * 32 + 8 * fq + 4 * n);
                        const f32x4 x1 = acc[ai][0][m][n], x2 = acc[ai][1][m][n]; o1[n] = x1 * c - x2 * s; o2[n] = x2 * c + x1 * s; sq += dot4(o1[n]) + dot4(o2[n]); }
                    sq += shx<16>(sq, fr | (fq << 4)); sq += shx<32>(sq, fr | (fq << 4)); mxr = __builtin_fmaxf(mxr, sq);
                    store8_bf16(kr + (size_t)row * 64 + 8 * fq, o1[0], o1[1]); store8_bf16(kr + (size_t)row * 64 + 32 + 8 * fq, o2[0], o2[1]); }
                wave16_atomic_max(nrm + CW_NKR + (u.pm >> 5), mxr, fr, fq);
            }
        }
    }
};
struct EpiUQ { EPI_HDR
    bf16_t* Q; const float* ssq_q; const float* rcos; const float* rsin; unsigned* ctl;
    DI void operator()(AccRef acc, const Unit& u, int wr, int wc, int fr, int fq) const {
        const int pn = u.pn, row0 = u.pm * 256 + wr * 64 + fr, c8 = wc * 32 + 8 * fq;
        float mxp[2] = {0.f, 0.f};
        FOR_ROWS { const int row = row0 + ai * 128 + m * 16; const float rs = __builtin_amdgcn_rsqf(ssq_q[row] * (1.0f / 768.0f) + EPS) * QSCALE_MLA;
            if (pn < 8) {
                FOR_BJ { const f32x4 v0 = acc[ai][bj][m][0] * rs, v1 = acc[ai][bj][m][1] * rs; float sq = dot4(v0) + dot4(v1);
                    sq += shx<16>(sq, fr | (fq << 4)); sq += shx<32>(sq, fr | (fq << 4)); mxp[bj] = __builtin_fmaxf(mxp[bj], sq);
                    store8_bf16(Q + (size_t)row * 3072 + (2 * pn + bj) * 192 + c8, v0, v1); }
            } else {
                const int head = 4 * (pn - 8) + wc, pos = row & (SEQ - 1);
                f32x4 o1[2], o2[2]; float sq = 0.f;
#pragma unroll
                for (int n = 0; n < 2; ++n) { const f32x4 c = *(const f32x4*)(rcos + pos * 32 + 8 * fq + 4 * n), s = *(const f32x4*)(rsin + pos * 32 + 8 * fq + 4 * n);
                    const f32x4 x1 = acc[ai][0][m][n] * rs, x2 = acc[ai][1][m][n] * rs; o1[n] = x1 * c - x2 * s; o2[n] = x2 * c + x1 * s; sq += dot4(o1[n]) + dot4(o2[n]); }
                sq += shx<16>(sq, fr | (fq << 4)); sq += shx<32>(sq, fr | (fq << 4)); mxp[0] = __builtin_fmaxf(mxp[0], sq);
                store8_bf16(Q + (size_t)row * 3072 + head * 192 + 128 + 8 * fq, o1[0], o1[1]); store8_bf16(Q + (size_t)row * 3072 + head * 192 + 160 + 8 * fq, o2[0], o2[1]);
            } }
        const int bb = u.pm >> 5;
        if (pn < 8) { FOR_BJ wave16_atomic_max(ctl + CW_NQ + ((bb * 16 + 2 * pn + bj) * 5 + wc), mxp[bj], fr, fq); }
        else wave16_atomic_max(ctl + CW_NQ + ((bb * 16 + 4 * (pn - 8) + wc) * 5 + 4), mxp[0], fr, fq);
    }
};
struct EpiUKV { EPI_HDR
    bf16_t* KV; const float* ssq_kv; unsigned* ctl;
    DI void operator()(AccRef acc, const Unit& u, int wr, int wc, int fr, int fq) const {
        const int row0 = u.pm * 256 + wr * 64 + fr, c8 = wc * 32 + 8 * fq;
        float mxk = 0.f;
        FOR_ROWS { const int row = row0 + ai * 128 + m * 16; const float rs = __builtin_amdgcn_rsqf(ssq_kv[row] * (1.0f / 512.0f) + EPS);
            FOR_BJ { const f32x4 v0 = acc[ai][bj][m][0] * rs, v1 = acc[ai][bj][m][1] * rs;
                if (bj == 0) { float sq = dot4(v0) + dot4(v1); sq += shx<16>(sq, fr | (fq << 4)); sq += shx<32>(sq, fr | (fq << 4)); mxk = __builtin_fmaxf(mxk, sq); }
                store8_bf16(KV + (size_t)row * 4096 + u.pn * 256 + bj * 128 + c8, v0, v1); } }
        wave16_atomic_max(ctl + CW_NK + (((u.pm >> 5) * 16 + u.pn) * 4 + wc), mxk, fr, fq);
    }
};
struct EpiMixA { EPI_HDR
    bf16_t* merged; const bf16_t* gates;
    DI void operator()(AccRef acc, const Unit& u, int wr, int wc, int fr, int fq) const {
        const int row0 = u.pm * 256 + wr * 64 + fr, c8 = wc * 32 + 8 * fq;
        FOR_ROWS { const int row = row0 + ai * 128 + m * 16;
            FOR_BJ { const int col = u.pn * 256 + bj * 128 + c8; f32x4 g0, g1; load8_bf16(gates + (size_t)row * 4096 + col, g0, g1);
                store8_bf16(merged + (size_t)row * 2048 + col, acc[ai][bj][m][0] * g0, acc[ai][bj][m][1] * g1); } }
    }
};
struct EpiMixB { EPI_HDR
    const bf16_t* gates; bf16_t* merged;
    DI void operator()(AccRef acc, const Unit& u, int wr, int wc, int fr, int fq) const {
        const int row0 = u.pm * 256 + wr * 64 + fr, c8 = wc * 32 + 8 * fq;
        FOR_ROWS { const int row = row0 + ai * 128 + m * 16;
            FOR_BJ { const int col = u.pn * 256 + bj * 128 + c8; f32x4 g0, g1; load8_bf16(gates + (size_t)row * 4096 + 2048 + col, g0, g1);
                f32x4 t0, t1; load8_bf16(merged + (size_t)row * 2048 + col, t0, t1);
                store8_bf16(merged + (size_t)row * 2048 + col, t0 + acc[ai][bj][m][0] * g0, t1 + acc[ai][bj][m][1] * g1); } }
    }
};
template <bool WITH_B> struct EpiRes { EPI_HDR
    const float* base; float* out; bf16_t* outb; float* ssq;
    DI void operator()(AccRef acc, const Unit& u, int wr, int wc, int fr, int fq) const {
        const int row0 = u.pm * 256 + wr * 64 + fr, c8 = wc * 32 + 8 * fq;
        FOR_ROWS { const int row = row0 + ai * 128 + m * 16; float s = 0.f;
            FOR_BJ { const size_t off = (size_t)row * 2048 + u.pn * 256 + bj * 128 + c8;
                const f32x4 v0 = *(const f32x4*)(base + off) + acc[ai][bj][m][0], v1 = *(const f32x4*)(base + off + 4) + acc[ai][bj][m][1];
                *(f32x4*)(out + off) = v0; *(f32x4*)(out + off + 4) = v1;
                if (WITH_B) { store8_bf16(outb + off, v0, v1); s += dot4(v0) + dot4(v1); } }
            if (WITH_B) { s += shx<16>(s, fr | (fq << 4)); s += shx<32>(s, fr | (fq << 4)); if (fq == 0) atomic_addf(ssq + row, s); } }
    }
};
struct EpiGU { EPI_HDR
    bf16_t* U; const float* ssq;
    DI void operator()(AccRef acc, const Unit& u, int wr, int wc, int fr, int fq) const {
        const int row0 = u.pm * 256 + wr * 64 + fr, c8 = wc * 32 + 8 * fq;
        FOR_ROWS { const int row = row0 + ai * 128 + m * 16; const float rs = __builtin_amdgcn_rsqf(ssq[row] * (1.0f / 2048.0f) + EPS);
            f32x4 o[2];
#pragma unroll
            for (int n = 0; n < 2; ++n) { const f32x4 gv = acc[ai][0][m][n] * rs, uv = acc[ai][1][m][n] * rs;
#pragma unroll
                for (int e = 0; e < 4; ++e) o[n][e] = gv[e] * sigmoidf_(gv[e]) * uv[e]; }
            store8_bf16(U + (size_t)row * D_FF + u.pn * 128 + c8, o[0], o[1]); }
    }
};

namespace att {
template <bool DIFF> struct Cfg;
template <> struct Cfg<false> { static constexpr int NKS = 12, NDT = 4, KSTR = 400, VSTR = 320, NST = 5; };
template <> struct Cfg<true>  { static constexpr int NKS = 8,  NDT = 8, KSTR = 528, VSTR = 576, NST = 8; };
DI f32x16 mfma32(bf16x8 a, bf16x8 b, f32x16 c) { return __builtin_amdgcn_mfma_f32_32x32x16_bf16(a, b, c, 0, 0, 0); }
DI s16x4 vtr(const LAS unsigned char* p) { return __builtin_bit_cast(s16x4, __builtin_amdgcn_ds_read_tr16_b64_v4i16((LAS s16x4*)p)); }
DI bf16x8 pack8(const f32x16& x, int s) {
    u32x4 p; p.x = cvtpk(x[8 * s + 0], x[8 * s + 1]); p.y = cvtpk(x[8 * s + 2], x[8 * s + 3]); p.z = cvtpk(x[8 * s + 4], x[8 * s + 5]); p.w = cvtpk(x[8 * s + 6], x[8 * s + 7]);
    return __builtin_bit_cast(bf16x8, p);
}

struct Tensors {
    const bf16_t* Q;   int q_pitch;
    const bf16_t* K;   int k_pitch;
    const bf16_t* V;
    const bf16_t* KR;
    bf16_t* Y;
    const float* sub_g; float lam;
    const unsigned* nrm; unsigned* qctr;
};

template <bool DIFF, bool NOMAX>
DI void unit(LAS unsigned char* lds, const Tensors& Tn, int b, int hd, int qb) {
    typedef Cfg<DIFF> C;
    constexpr int NKS = C::NKS, NDT = C::NDT, KSTR = C::KSTR, VSTR = C::VSTR, NST = C::NST;
    constexpr int K_BYTES = 64 * KSTR, V_BYTES = 64 * VSTR, STAGE = K_BYTES + V_BYTES;
    int tid_ = threadIdx.x; asm volatile("" : "+v"(tid_));
    const int tid = tid_, w = __builtin_amdgcn_readfirstlane(tid >> 6), lane = tid & 63, r = lane & 31, h = lane >> 5;
    const int wq = DIFF ? (w & 3) : w, map = DIFF ? (w >> 2) : 0;
    const int q0 = DIFF ? qb * 128 + 32 * wq : qb * 256 + 32 * wq;
    const int need = (q0 >> 6) + 1;
    const int ntiles = DIFF ? 2 * qb + 2 : 4 * qb + 4;
    int jst = 0, jbeg = 0;
    const float sl2 = DIFF ? __builtin_amdgcn_exp2f(-(float)(hd + 1)) * LOG2E : 0.f;
    if (DIFF) {
        float wd[2];
#pragma unroll
        for (int mp = 0; mp < 2; ++mp) { const unsigned* nq = Tn.nrm + (((b * 8 + hd) * 2 + mp) * 2 + 0) * 4; const unsigned* nk = nq + 4;
            const float sq = (__builtin_bit_cast(float, nq[0]) + __builtin_bit_cast(float, nq[1])) + (__builtin_bit_cast(float, nq[2]) + __builtin_bit_cast(float, nq[3]));
            const float sk = (__builtin_bit_cast(float, nk[0]) + __builtin_bit_cast(float, nk[1])) + (__builtin_bit_cast(float, nk[2]) + __builtin_bit_cast(float, nk[3]));
            const float B2 = __builtin_sqrtf(sq * sk) * 1.02f;
            wd[mp] = (152.0f + 2.0f * B2) / sl2; }
        const float lim = (float)(q0 - 63) - wd[map], limb = (float)(qb * 128 - 63) - __builtin_fmaxf(wd[0], wd[1]);
        jst = lim > 0.f ? (int)__builtin_ceilf(lim * (1.0f / 64.0f)) : 0; jbeg = limb > 0.f ? (int)__builtin_ceilf(limb * (1.0f / 64.0f)) : 0;
        jst = __builtin_amdgcn_readfirstlane(jst); jbeg = __builtin_amdgcn_readfirstlane(jbeg);
        if (jst < jbeg) jst = jbeg;
    }
    const size_t tok0 = (size_t)b * SEQ;

    if (w >= 4) __builtin_amdgcn_s_setprio(1);
    bf16x8 qf[NKS];
    {
        const bf16_t* qp = Tn.Q + (tok0 + q0 + r) * Tn.q_pitch + (DIFF ? hd * 256 + map * 128 : hd * 192) + 8 * h;
#pragma unroll
        for (int ks = 0; ks < NKS; ++ks) qf[ks] = *(const bf16x8*)(qp + 16 * ks);
    }
    constexpr int NP = STAGE / 1024, NPW = (NP + 7) / 8, KCH = DIFF ? 32 : 24, VCH = DIFF ? 32 : 16;
    unsigned goff[NPW];
#pragma unroll
    for (int i = 0; i < NPW; ++i) {
        const int ob = (w + 8 * i) * 1024 + lane * 16; unsigned off;
        if (ob < K_BYTES) { const int row = ob / KSTR, ch = (ob % KSTR) / 16;
            if (DIFF) off = (ch < KCH) ? (unsigned)((row * 6144 + 2048 + hd * 256 + ch * 8) * 2) : 0u;
            else off = (ch < 16) ? (unsigned)((row * 4096 + hd * 256 + ch * 8) * 2) : (ch < KCH ? (0x80000000u | (unsigned)((row * 64 + (ch - 16) * 8) * 2)) : 0u);
        } else { const int o2 = ob - K_BYTES, row = o2 / VSTR, ch = (o2 % VSTR) / 16;
            if (DIFF) off = (ch < VCH && row < 64) ? (unsigned)((row * 6144 + 4096 + hd * 256 + ch * 8) * 2) : 0u;
            else off = (ch < VCH && row < 64) ? (unsigned)((row * 4096 + hd * 256 + 128 + ch * 8) * 2) : 0u;
        }
        goff[i] = off;
    }
    const char* kvbase = (const char*)(DIFF ? Tn.Q : Tn.K) + tok0 * (DIFF ? 6144 : 4096) * 2;
    const char* krbase = DIFF ? kvbase : (const char*)Tn.KR + tok0 * 64 * 2;
#define ATT_ISSUE(j, buf) do { const char* kvb = kvbase + (size_t)(j) * 64 * (DIFF ? 6144 : 4096) * 2; const char* krb = krbase + (size_t)(j) * 64 * 64 * 2; \
        _Pragma("unroll") for (int i = 0; i < NPW; ++i) { if (w + 8 * i < NP) { \
            const char* src = (!DIFF && (goff[i] & 0x80000000u)) ? krb + (goff[i] & 0x7fffffffu) : kvb + goff[i]; \
            __builtin_amdgcn_global_load_lds((const unsigned*)src, (LAS unsigned*)(lds + (buf) * STAGE + (w + 8 * i) * 1024), 16, 0, 0); } } } while (0)

    f32x16 o[NDT];
#pragma unroll
    for (int dt = 0; dt < NDT; ++dt)
#pragma unroll
        for (int e = 0; e < 16; ++e) o[dt][e] = 0.f;
    float mrow = 0.f, lrow = 0.f;
    const int i16 = lane & 15, tq = i16 >> 2, tp = i16 & 3, g16 = (lane >> 4) & 1;
    const unsigned koff = r * KSTR + h * 16 + (DIFF ? map * 256 : 0);
    const unsigned voff = K_BYTES + (4 * h + tq) * VSTR + (16 * g16 + 4 * tp) * 2;

    constexpr int NSTG = DIFF ? 2 : 3;
    const bool full_w = (w + 8 * (NPW - 1) < NP);
    int sb = 0;
    ATT_ISSUE(jbeg, 0);
    if (NSTG == 3 && jbeg + 1 < ntiles) ATT_ISSUE(jbeg + 1, 1);
    if (NSTG == 3 && jbeg + 1 < ntiles) { if (full_w) asm volatile("s_waitcnt vmcnt(%0)" :: "n"(NPW) : "memory"); else asm volatile("s_waitcnt vmcnt(%0)" :: "n"(NPW - 1) : "memory"); }
    else asm volatile("s_waitcnt vmcnt(0)" ::: "memory");
    __builtin_amdgcn_s_barrier();
    for (int j = jbeg; j < ntiles; ++j) {
        const int sbn = (sb + NSTG - 1 >= NSTG) ? sb - 1 : sb + NSTG - 1;
        if (j + NSTG - 1 < ntiles) ATT_ISSUE(j + NSTG - 1, sbn);
        if (j >= jst && j < need) {
            const LAS unsigned char* kb = lds + sb * STAGE + koff;
            const unsigned vba = (unsigned)(uintptr_t)(lds + sb * STAGE + voff);
            constexpr int DK = DIFF ? (NOMAX ? 4 : 2) : 6, DV = DIFF ? (NOMAX ? 2 : 1) : 4, NPV = 2 * NDT;
            bf16x8 kf[DK]; s16x4 vlo[DV], vhi[DV];
#define SGB(mask, n) __builtin_amdgcn_sched_group_barrier(mask, n, 0)
#define LDK(hf_, ks_) (*(const LAS bf16x8*)(kb + (hf_) * 32 * KSTR + (ks_) * 32))
#define VTR(dst_, off_) asm volatile("ds_read_b64_tr_b16 %0, %1 offset:%c2" : "=v"(dst_) : "v"(vba), "i"(off_) : "memory")
#define LDV(i_, hf_) do { VTR(vlo[(i_) % DV], (16 * (2 * (hf_) + ((i_) & 1))) * VSTR + 64 * ((i_) >> 1)); VTR(vhi[(i_) % DV], (16 * (2 * (hf_) + ((i_) & 1)) + 8) * VSTR + 64 * ((i_) >> 1)); } while (0)
#define VWAIT(n_, a_, b_) asm volatile("s_waitcnt lgkmcnt(%c2)" : "+v"(a_), "+v"(b_) : "i"(n_) : "memory")
#pragma unroll
            for (int i = 0; i < DK; ++i) kf[i] = LDK(0, i);
            SGB(0x100, DK);
#pragma unroll
            for (int hf = 0; hf < 2; ++hf) {
                const bool offd = DIFF && (j < need - 1);
                f32x16 sc;
                if (offd) {
                    const float A = sl2 * (float)(64 * j + 32 * hf + 4 * h - q0) - (NOMAX ? 0.f : mrow);
                    float tg[4] = {A, __builtin_fmaf(sl2, 8.f, A), __builtin_fmaf(sl2, 16.f, A), __builtin_fmaf(sl2, 24.f, A)};
#pragma unroll
                    for (int g = 0; g < 4; ++g) asm volatile("" : "+v"(tg[g]));
#pragma unroll
                    for (int e = 0; e < 16; ++e) sc[e] = __builtin_fmaf(sl2, (float)(e & 3), tg[e >> 2]);
                } else {
                    const float base = (DIFF ? sl2 * (float)r : 0.f) - (NOMAX ? 0.f : mrow);
#pragma unroll
                    for (int e = 0; e < 16; ++e) sc[e] = base;
                }
#pragma unroll
                for (int ks = 0; ks < NKS; ++ks) {
                    sc = mfma32(kf[ks % DK], qf[ks], sc);
                    if (ks + DK < NKS) kf[ks % DK] = LDK(hf, ks + DK);
                }
#pragma unroll
                for (int ks = 0; ks < NKS; ++ks) { SGB(0x8, 1); if (ks + DK < NKS) SGB(0x100, 1); }
                __builtin_amdgcn_sched_barrier(0);
#pragma unroll
                for (int i = 0; i < DV; ++i) LDV(i, hf);
                if (DIFF && !offd) {
                    const float qk = (float)(q0 + r - 64 * j - 4 * h - 32 * hf);
                    float tq[4] = {qk, qk - 8.f, qk - 16.f, qk - 24.f};
#pragma unroll
                    for (int g = 0; g < 4; ++g) asm volatile("" : "+v"(tq[g]));
#pragma unroll
                    for (int e = 0; e < 16; ++e) sc[e] = __builtin_fmaf(-sl2, __builtin_fabsf(tq[e >> 2] - (float)(e & 3)), sc[e]);
                }
                float mx = sc[0];
                if (!NOMAX) {
#pragma unroll
                for (int e = 1; e < 16; ++e) mx = __builtin_fmaxf(mx, sc[e]);
                { auto rr = __builtin_amdgcn_permlane32_swap(__builtin_bit_cast(unsigned, mx), __builtin_bit_cast(unsigned, mx), false, false);
                  mx = __builtin_fmaxf(__builtin_bit_cast(float, rr[0]), __builtin_bit_cast(float, rr[1])); }
                }
                const bool first = (j == jst) && (hf == 0);
                if (!NOMAX && (first || __any(mx > 8.0f))) {
                    const float mn = first ? mx : __builtin_fmaxf(mx, 0.f), al = first ? 1.0f : fast_exp2(-mn);
#pragma unroll
                    for (int dt = 0; dt < NDT; ++dt) o[dt] = o[dt] * al;
                    lrow *= al; mrow += mn;
#pragma unroll
                    for (int e = 0; e < 16; ++e) sc[e] -= mn;
                }
                f32x2_t ps2 = {0.f, 0.f};
#pragma unroll
                for (int e = 0; e < 16; e += 2) { sc[e] = fast_exp2(sc[e]); sc[e + 1] = fast_exp2(sc[e + 1]); ps2 += (f32x2_t){sc[e], sc[e + 1]}; }
                lrow += ps2.x + ps2.y;
                bf16x8 pb[2]; pb[0] = pack8(sc, 0); pb[1] = pack8(sc, 1);
#pragma unroll
                for (int i = 0; i < NPV; ++i) {
                    VWAIT(2 * ((NPV - 1 - i) < (DV - 1) ? (NPV - 1 - i) : (DV - 1)), vlo[i % DV], vhi[i % DV]);
                    const bf16x8 vf = __builtin_shufflevector(vlo[i % DV], vhi[i % DV], 0, 1, 2, 3, 4, 5, 6, 7);
                    o[i >> 1] = mfma32(vf, pb[i & 1], o[i >> 1]);
                    if (i + DV < NPV) LDV(i + DV, hf);
                }
                __builtin_amdgcn_sched_barrier(0);
                if (hf == 0) {
#pragma unroll
                    for (int i = 0; i < DK; ++i) kf[i] = LDK(1, i);
                    SGB(0x100, DK);
                }
            }
#undef SGB
#undef LDK
#undef VTR
#undef LDV
#undef VWAIT
        }
        if (NSTG == 3 && j + 2 < ntiles) { if (full_w) asm volatile("s_waitcnt vmcnt(%0) lgkmcnt(0)" :: "n"(NPW) : "memory"); else asm volatile("s_waitcnt vmcnt(%0) lgkmcnt(0)" :: "n"(NPW - 1) : "memory"); }
        else asm volatile("s_waitcnt vmcnt(0) lgkmcnt(0)" ::: "memory");
        __builtin_amdgcn_s_barrier();
        sb = (sb + 1 == NSTG) ? 0 : sb + 1;
    }
#undef ATT_ISSUE
    __builtin_amdgcn_s_setprio(0);
    int tid2_ = threadIdx.x; asm volatile("" : "+v"(tid2_));
    const int lane2 = tid2_ & 63, w2 = __builtin_amdgcn_readfirstlane(tid2_ >> 6), wq2 = DIFF ? (w2 & 3) : w2, map2 = DIFF ? (w2 >> 2) : 0;
    const int r2 = lane2 & 31, h2 = lane2 >> 5, q02 = DIFF ? qb * 128 + 32 * wq2 : qb * 256 + 32 * wq2;
    const float ltot = lrow + shx<32>(lrow, lane2);
    const float inv = 1.0f / ltot;
    if (!DIFF) {
        bf16_t* yp = Tn.Y + (tok0 + q02 + r2) * 2048 + hd * 128 + 4 * h2;
#pragma unroll
        for (int dt = 0; dt < NDT; ++dt)
#pragma unroll
            for (int g = 0; g < 4; ++g) { u32x2 pk; pk.x = cvtpk(o[dt][4 * g] * inv, o[dt][4 * g + 1] * inv); pk.y = cvtpk(o[dt][4 * g + 2] * inv, o[dt][4 * g + 3] * inv);
                *(u32x2*)(yp + 32 * dt + 8 * g) = pk; }
    } else {
        LAS float* X = (LAS float*)lds;
        if (map2 == 1) {
#pragma unroll
            for (int dt = 0; dt < NDT; ++dt)
#pragma unroll
                for (int e = 0; e < 16; ++e) X[(wq2 * 128 + dt * 16 + e) * 64 + lane2] = o[dt][e] * inv;
        }
        __syncthreads();
        if (map2 == 0) {
            float ss = 0.f;
#pragma unroll
            for (int dt = 0; dt < NDT; ++dt)
#pragma unroll
                for (int e = 0; e < 16; ++e) { const float v = o[dt][e] * inv - Tn.lam * X[(wq2 * 128 + dt * 16 + e) * 64 + lane2]; o[dt][e] = v; ss += v * v; }
            ss += shx<32>(ss, lane2);
            const float rs = __builtin_amdgcn_rsqf(ss * (1.0f / 256.0f) + EPS) * (1.0f - LAMBDA_INIT);
            bf16_t* yp = Tn.Y + (tok0 + q02 + r2) * 2048 + hd * 256 + 4 * h2;
#pragma unroll
            for (int dt = 0; dt < NDT; ++dt)
#pragma unroll
                for (int g = 0; g < 4; ++g) { const f32x4 gg = *(const f32x4*)(Tn.sub_g + 32 * dt + 8 * g + 4 * h2);
                    u32x2 pk; pk.x = cvtpk(o[dt][4 * g] * rs * gg[0], o[dt][4 * g + 1] * rs * gg[1]); pk.y = cvtpk(o[dt][4 * g + 2] * rs * gg[2], o[dt][4 * g + 3] * rs * gg[3]);
                    *(u32x2*)(yp + 32 * dt + 8 * g) = pk; }
        }
        __syncthreads();
    }
}

template <bool DIFF>
DI float score_bound(const Tensors& Tn, int b, int hd) {
    float bound;
    if (DIFF) {
        bound = 0.f;
#pragma unroll
        for (int mp = 0; mp < 2; ++mp) { const unsigned* nq = Tn.nrm + (((b * 8 + hd) * 2 + mp) * 2 + 0) * 4; const unsigned* nk = nq + 4;
            const float sq = (__builtin_bit_cast(float, nq[0]) + __builtin_bit_cast(float, nq[1])) + (__builtin_bit_cast(float, nq[2]) + __builtin_bit_cast(float, nq[3]));
            const float sk = (__builtin_bit_cast(float, nk[0]) + __builtin_bit_cast(float, nk[1])) + (__builtin_bit_cast(float, nk[2]) + __builtin_bit_cast(float, nk[3]));
            bound = __builtin_fmaxf(bound, __builtin_sqrtf(sq * sk) * 1.02f); }
    } else {
        const unsigned* nq = Tn.nrm + CW_NQ + (b * 16 + hd) * 5; const unsigned* nk = Tn.nrm + CW_NK + (b * 16 + hd) * 4;
        const float sq = (__builtin_bit_cast(float, nq[0]) + __builtin_bit_cast(float, nq[1])) + (__builtin_bit_cast(float, nq[2]) + __builtin_bit_cast(float, nq[3])) + __builtin_bit_cast(float, nq[4]);
        const float sk = (__builtin_bit_cast(float, nk[0]) + __builtin_bit_cast(float, nk[1])) + (__builtin_bit_cast(float, nk[2]) + __builtin_bit_cast(float, nk[3])) + __builtin_bit_cast(float, Tn.nrm[CW_NKR + b]);
        bound = __builtin_sqrtf(sq * sk) * 1.02f;
    }
    return __builtin_bit_cast(float, __builtin_amdgcn_readfirstlane(__builtin_bit_cast(int, bound)));
}

template <bool DIFF>
DI void phase(LAS unsigned char* lds, const Tensors& Tn) {
    constexpr int NQ = DIFF ? 64 : 32, NBH = DIFF ? 16 : 32, HALFQ = NQ / 2, NPAIR = NBH * HALFQ;
    const int G = gridDim.x, c = blockIdx.x;
    if (DIFF) {
        LAS unsigned* slot = (LAS unsigned*)(lds + LDS_BYTES - 64);
        if (threadIdx.x == 0) slot[1] = 0u;
        __syncthreads();
        for (;;) {
            const unsigned qi = slot[1];
            if (qi >= 8u) break;
            const int q = (int)((blockIdx.x + qi) & 7u);
            if (threadIdx.x == 0) slot[0] = __hip_atomic_fetch_add(Tn.qctr + 16 * q, 1u, __ATOMIC_RELAXED, __HIP_MEMORY_SCOPE_AGENT);
            __syncthreads();
            const unsigned uu = slot[0];
            __syncthreads();
            if (uu >= 128u) { if (threadIdx.x == 0) slot[1] = qi + 1u; __syncthreads(); continue; }
            const int bq = q >> 2, hq = (uu & 1u) ? 7 - (q & 3) : (q & 3), qbx = 63 - (int)(uu >> 1);
            if (score_bound<DIFF>(Tn, bq, hq) < 75.0f) unit<DIFF, true>(lds, Tn, bq, hq, qbx); else unit<DIFF, false>(lds, Tn, bq, hq, qbx);
        }
        return;
    }
    for (int p = c; p < NPAIR; p += G) {
        int bh, a;
        if (G == 256) { const int xcd = c & 7, idx = (c >> 3) + 32 * (p / 256); bh = xcd * (NBH / 8) + idx / HALFQ; a = idx % HALFQ; }
        else { bh = p / HALFQ; a = p % HALFQ; }
        const int b = bh / (NBH / 2), hd = bh % (NBH / 2);
        if (score_bound<DIFF>(Tn, b, hd) < 100.0f) { unit<DIFF, true>(lds, Tn, b, hd, NQ - 1 - a); unit<DIFF, true>(lds, Tn, b, hd, a); }
        else { unit<DIFF, false>(lds, Tn, b, hd, NQ - 1 - a); unit<DIFF, false>(lds, Tn, b, hd, a); }
    }
}
}

struct TrItem { const float* W; int srcN, src, K; bf16_t* WT; int dst_row, k0; const float* gain; };
DI void tr_load(const TrItem& t, f32x4 (&v)[8], int lane) {
    if (t.src < 0) return;
    const float* wp = t.W + (size_t)(t.k0 + (lane >> 3)) * t.srcN + t.src + (lane & 7) * 4;
#pragma unroll
    for (int i = 0; i < 8; ++i) v[i] = *(const f32x4*)(wp + (size_t)(8 * i) * t.srcN);
}
DI void tr_store(const TrItem& t, const f32x4 (&v)[8], LAS float* scr, int lane) {
    const int c = lane & 7, K = t.K;
    if (t.src < 0) {
#pragma unroll
        for (int j = 0; j < 4; ++j) { const int n = (lane >> 3) + 8 * j; *(u32x4*)(t.WT + (size_t)(t.dst_row + n) * K + t.k0 + 8 * c) = (u32x4){0u, 0u, 0u, 0u}; }
        return;
    }
    { const int kk = lane >> 3, c4 = (lane & 7) * 4;
#pragma unroll
      for (int i = 0; i < 8; ++i) { const float gn = t.gain ? t.gain[t.k0 + 8 * i + kk] : 1.0f; LAS float* sp = scr + (8 * i + kk) * 33 + c4;
          sp[0] = v[i][0] * gn; sp[1] = v[i][1] * gn; sp[2] = v[i][2] * gn; sp[3] = v[i][3] * gn; } }
    asm volatile("s_waitcnt lgkmcnt(0)" ::: "memory");
#pragma unroll
    for (int j = 0; j < 4; ++j) { const int n = (lane >> 3) + 8 * j; const LAS float* sp = scr + (8 * c) * 33 + n;
        u32x4 o; o.x = cvtpk(sp[0 * 33], sp[1 * 33]); o.y = cvtpk(sp[2 * 33], sp[3 * 33]); o.z = cvtpk(sp[4 * 33], sp[5 * 33]); o.w = cvtpk(sp[6 * 33], sp[7 * 33]);
        *(u32x4*)(t.WT + (size_t)(t.dst_row + n) * K + t.k0 + 8 * c) = o; }
    asm volatile("s_waitcnt lgkmcnt(0)" ::: "memory");
}

typedef const __attribute__((address_space(4))) Args* KArgs;
DI KArgs fresh_args() { KArgs p = (KArgs)__builtin_amdgcn_kernarg_segment_ptr(); asm volatile("" : "+s"(p)); return p; }
enum { SEG_IN = 0, SEG_UQ, SEG_UKV, SEG_MLA, SEG_DIFF, SEG_OUT, SEG_GU, SEG_DN, NSEG };

DI void convert_weights(KArgs a, LAS unsigned char* lds, int seg_lo, int seg_hi, int gw, int NGW);
DI void prologue(KArgs a, LAS unsigned char* lds) {
    unsigned char* ws = a->ws;
    int tid_ = threadIdx.x; asm volatile("" : "+v"(tid_));
    const int tid = tid_, lane = tid & 63, wave = __builtin_amdgcn_readfirstlane(tid >> 6);
    const int G = gridDim.x, gw = blockIdx.x * 8 + wave, NGW = G * 8, gt = blockIdx.x * 512 + tid, NGT = G * 512;
    { float* ssq = (float*)(ws + WS_SSQ); for (int i = gt; i < 3 * T + 1024; i += NGT) ssq[i] = 0.f; }
    { float* rc = (float*)(ws + WS_ROPE_C); float* rsn = (float*)(ws + WS_ROPE_S);
      for (int i = gt; i < SEQ * 32; i += NGT) { const int pos = i >> 5, f = i & 31;
          const float inv = (float)exp2(-(double)f * 0.4152410118609203);
          const float ang = (float)pos * inv;
          const double t = (double)ang * 0.15915494309189535;
          const float fr = (float)(t - rint(t));
          rc[i] = __builtin_amdgcn_cosf(fr); rsn[i] = __builtin_amdgcn_sinf(fr); } }
    { bf16_t* H = (bf16_t*)(ws + WS_H);
      for (int row = gw; row < T; row += 2 * NGW) {
          const int row1 = row + NGW; const bool two = row1 < T;
          const f32x4* xr0 = (const f32x4*)(a->x + (size_t)row * DM) + lane; const f32x4* xr1 = (const f32x4*)(a->x + (size_t)(two ? row1 : row) * DM) + lane;
          f32x4 v0[8], v1[8]; float s0 = 0.f, s1 = 0.f;
#pragma unroll
          for (int j = 0; j < 8; ++j) v0[j] = xr0[64 * j];
#pragma unroll
          for (int j = 0; j < 8; ++j) v1[j] = xr1[64 * j];
#pragma unroll
          for (int j = 0; j < 8; ++j) { s0 += dot4(v0[j]); s1 += dot4(v1[j]); }
          const float rs0 = __builtin_amdgcn_rsqf(wave_sum(s0, lane) * (1.0f / DM) + EPS), rs1 = __builtin_amdgcn_rsqf(wave_sum(s1, lane) * (1.0f / DM) + EPS);
          u32x2* o0 = (u32x2*)(H + (size_t)row * DM) + lane; u32x2* o1 = (u32x2*)(H + (size_t)row1 * DM) + lane;
#pragma unroll
          for (int j = 0; j < 8; ++j) { const f32x4 g = *((const f32x4*)a->attn_norm_g + lane + 64 * j); const f32x4 y0 = v0[j] * rs0 * g, y1 = v1[j] * rs1 * g;
              u32x2 pk; pk.x = cvtpk(y0[0], y0[1]); pk.y = cvtpk(y0[2], y0[3]); o0[64 * j] = pk;
              if (two) { u32x2 pk1; pk1.x = cvtpk(y1[0], y1[1]); pk1.y = cvtpk(y1[2], y1[3]); o1[64 * j] = pk1; } } } }
    convert_weights(a, lds, SEG_IN, SEG_IN + 1, gw, NGW);
}

DI void convert_weights(KArgs a, LAS unsigned char* lds, int seg_lo, int seg_hi, int gw, int NGW) {
    unsigned char* ws = a->ws;
    int tid_ = threadIdx.x; asm volatile("" : "+v"(tid_));
    const int lane = tid_ & 63, wave = __builtin_amdgcn_readfirstlane(tid_ >> 6);
    LAS float* scr = (LAS float*)(lds + wave * 16384);
    int base = 0;
#pragma unroll 1
    for (int seg = seg_lo; seg < seg_hi; ++seg) {
        int K, ngr;
        switch (seg) { case SEG_IN: K = 2048; ngr = N_IN_PAD / 32; break; case SEG_UQ: K = 768; ngr = 96; break; case SEG_UKV: K = 512; ngr = 128; break;
                       case SEG_GU: K = 2048; ngr = 352; break; case SEG_DN: K = D_FF; ngr = 64; break; default: K = 2048; ngr = 64; break; }
        const int nkb = K / 64, nitems = ngr * nkb;
        const int first = (int)(((long)gw - base % NGW + NGW) % NGW);
#define DECODE_ITEM(it_, T_) do { const int g = (it_) % ngr, k0 = ((it_) / ngr) * 64; \
            const float* W; int srcN, src; bf16_t* WT; const float* gain = nullptr; \
            switch (seg) { \
            case SEG_IN: { W = a->w_in; srcN = D_IN; WT = (bf16_t*)(ws + WS_WT_IN); const int n0 = g * 32; \
            if (n0 < 1280) src = n0; else if (n0 < 7424) src = n0 + 64; else if (n0 < 11520) src = n0 + 64; \
            else { const int j = n0 - 11520; src = (j == 0) ? 1280 : (j == 128 ? 1312 : -1); } } break; \
            case SEG_UQ: { W = a->w_uq; srcN = 3072; WT = (bf16_t*)(ws + WS_WT_UQ); gain = a->q_norm_g; \
            if (g < 64) src = (g >> 2) * 192 + (g & 3) * 32; \
            else { const int gp = g - 64, t = gp >> 3, j = gp & 7; src = (4 * t + (j & 3)) * 192 + 128 + (j >> 2) * 32; } } break; \
            case SEG_UKV: W = a->w_ukv; srcN = 4096; WT = (bf16_t*)(ws + WS_WT_UKV); gain = a->kv_norm_g; src = g * 32; break; \
            case SEG_MLA: W = a->w_mla_proj; srcN = 2048; WT = (bf16_t*)(ws + WS_WT_MLA); src = g * 32; break; \
            case SEG_DIFF: W = a->w_diff_proj; srcN = 2048; WT = (bf16_t*)(ws + WS_WT_DIFF); src = g * 32; break; \
            case SEG_OUT: W = a->w_out; srcN = 2048; WT = (bf16_t*)(ws + WS_WT_OUT); src = g * 32; break; \
            case SEG_GU: { const int t = g >> 3, j = g & 7; W = (j < 4) ? a->w_ffn_gate : a->w_ffn_up; srcN = D_FF; WT = (bf16_t*)(ws + WS_WT_GU); gain = a->ffn_norm_g; src = 128 * t + 32 * (j & 3); } break; \
            default: W = a->w_ffn_down; srcN = 2048; WT = (bf16_t*)(ws + WS_WT_DN); src = g * 32; break; \
            } \
            T_.W = W; T_.srcN = srcN; T_.src = src; T_.K = K; T_.WT = WT; T_.dst_row = g * 32; T_.k0 = k0; T_.gain = gain; } while (0)
#pragma unroll 1
        for (int it = first; it < nitems; it += 2 * NGW) {
            TrItem t0, t1; f32x4 v0[8], v1[8]; const bool two = (it + NGW < nitems);
            DECODE_ITEM(it, t0); tr_load(t0, v0, lane);
            if (two) { DECODE_ITEM(it + NGW, t1); tr_load(t1, v1, lane); }
            tr_store(t0, v0, scr, lane);
            if (two) tr_store(t1, v1, scr, lane);
        }
#undef DECODE_ITEM
        base += nitems;
    }
}


#define XB_TMO      128
#define XB_XCNT(j)  (256  + 64 * (j))
#define XB_XSUB(j)  (1280 + 64 * (j))
#define XB_XGEN(j)  (2304 + 64 * (j))
#define XB_TOP      3328
#define XB_TOPGEN   3392
#define XCD_BAR_WORDS 3456
#define XB_SPIN_CAP (1u << 18)
DI unsigned xb_ld(unsigned* p)              { return __hip_atomic_load(p, __ATOMIC_RELAXED, __HIP_MEMORY_SCOPE_AGENT); }
DI unsigned xb_add(unsigned* p, unsigned v) { return __hip_atomic_fetch_add(p, v, __ATOMIC_RELAXED, __HIP_MEMORY_SCOPE_AGENT); }
DI unsigned xb_xcc_id() { return (unsigned)__builtin_amdgcn_s_getreg((3 << 11) | 20) & 0xFu; }
#define XB_SPIN(cond, bar) do { unsigned _sp = 0; while (cond) { __builtin_amdgcn_s_sleep(1); \
    if ((++_sp & 255u) == 0u) { if (xb_ld(&(bar)[XB_TMO])) break; if (_sp > XB_SPIN_CAP) { atomicAdd(&(bar)[XB_TMO], 1u); break; } } } } while (0)
struct XcdBarrier { unsigned* bar; unsigned x; volatile LAS unsigned* st; };
DI XcdBarrier xcd_barrier_post(unsigned* bar, volatile LAS unsigned* st) {
    XcdBarrier b; b.bar = bar; b.x = xb_xcc_id(); b.st = st;
    if (threadIdx.x == 0) (void)xb_add(&bar[XB_XCNT(b.x)], 1u);
    return b;
}
DI void xcd_barrier_complete(unsigned* bar, unsigned x, unsigned& nloc, unsigned& nx) {
    const unsigned G = gridDim.x * gridDim.y * gridDim.z;
    unsigned sum, cnt, mine, sp = 0u;
    for (;;) {
        sum = 0u; cnt = 0u; mine = 0u;
#pragma unroll
        for (unsigned j = 0; j < 16; ++j) { const unsigned c = xb_ld(&bar[XB_XCNT(j)]); sum += c; cnt += (c > 0u) ? 1u : 0u; mine = (j == x) ? c : mine; }
        if (sum == G) break;
        __builtin_amdgcn_s_sleep(1);
        if ((++sp & 255u) == 0u) { if (xb_ld(&bar[XB_TMO])) break; if (sp > XB_SPIN_CAP) { atomicAdd(&bar[XB_TMO], 1u); break; } }
    }
    nloc = mine > 0u ? mine : 1u; nx = cnt > 0u ? cnt : 1u;
}
DI void xcd_barrier(const XcdBarrier& b) {
    asm volatile("s_waitcnt vmcnt(0)" ::: "memory");
    __syncthreads();
    if (threadIdx.x == 0) {
        unsigned* bar = b.bar;
        __builtin_amdgcn_s_waitcnt(0);
        unsigned nloc = b.st[0], nx = b.st[1];
        if (nloc == 0u) { xcd_barrier_complete(bar, b.x, nloc, nx); b.st[0] = nloc; b.st[1] = nx; }
        const unsigned old = xb_add(&bar[XB_XSUB(b.x)], 1u);
        const unsigned gen = old / nloc;
        if (old + 1u == (gen + 1u) * nloc) {
            __builtin_amdgcn_fence(__ATOMIC_RELEASE, "agent");
            asm volatile("s_waitcnt vmcnt(0)" ::: "memory");
            const unsigned og = xb_add(&bar[XB_TOP], 1u);
            const unsigned tg = og / nx;
            if (og + 1u == (tg + 1u) * nx) xb_add(&bar[XB_TOPGEN], 1u);
            else XB_SPIN(xb_ld(&bar[XB_TOPGEN]) == tg, bar);
            __builtin_amdgcn_fence(__ATOMIC_ACQUIRE, "agent");
            xb_add(&bar[XB_XGEN(b.x)], 1u);
            asm volatile("s_waitcnt vmcnt(0)" ::: "memory");
        } else {
            XB_SPIN(xb_ld(&bar[XB_XGEN(b.x)]) == gen, bar);
            __builtin_amdgcn_fence(__ATOMIC_ACQUIRE, "agent");
            asm volatile("s_waitcnt vmcnt(0)" ::: "memory");
        }
    }
    __syncthreads();
}

__global__ void __launch_bounds__(512, 2) fwd_kernel(Args a_unused) {
    extern __shared__ __attribute__((aligned(16))) unsigned char lds_raw[];
    LAS unsigned char* lds = (LAS unsigned char*)lds_raw;
    cg::grid_group grid = cg::this_grid();
    volatile LAS unsigned* xst = (volatile LAS unsigned*)(lds + LDS_BYTES - 32);
    if (threadIdx.x == 0) { xst[0] = 0u; xst[1] = 0u; }
    unsigned char* ws = fresh_args()->ws; float* const outp = fresh_args()->out;
    const int G = gridDim.x, cidx = blockIdx.x;
    bf16_t* WT_IN = (bf16_t*)(ws + WS_WT_IN); bf16_t* WT_UQ = (bf16_t*)(ws + WS_WT_UQ); bf16_t* WT_UKV = (bf16_t*)(ws + WS_WT_UKV); bf16_t* WT_MLA = (bf16_t*)(ws + WS_WT_MLA);
    bf16_t* WT_DIFF = (bf16_t*)(ws + WS_WT_DIFF); bf16_t* WT_OUT = (bf16_t*)(ws + WS_WT_OUT); bf16_t* WT_GU = (bf16_t*)(ws + WS_WT_GU); bf16_t* WT_DN = (bf16_t*)(ws + WS_WT_DN);
    float* RC = (float*)(ws + WS_ROPE_C); float* RS = (float*)(ws + WS_ROPE_S);
    float* SSQ_Q = (float*)(ws + WS_SSQ); float* SSQ_KV = SSQ_Q + T; float* SSQ_F = SSQ_KV + T;
    unsigned* CTL = (unsigned*)(ws + WS_CTL);
    bf16_t* KR = (bf16_t*)(ws + WS_KR); bf16_t* H = (bf16_t*)(ws + WS_H); bf16_t* YDIFF = H;
    bf16_t* DQKV = (bf16_t*)(ws + WS_R1); bf16_t* Qb = (bf16_t*)(ws + WS_R1); bf16_t* KVb = Qb + (size_t)T * 3072;
    bf16_t* MERGED = (bf16_t*)(ws + WS_R1 + (size_t)T * 2048 * 4); bf16_t* Ub = (bf16_t*)(ws + WS_R1);
    bf16_t* CQKV = (bf16_t*)(ws + WS_R2); bf16_t* YMLA = (bf16_t*)(ws + WS_R2); bf16_t* X1B = (bf16_t*)(ws + WS_R2);
    bf16_t* GATES = (bf16_t*)outp;

    { unsigned* bw = (unsigned*)(ws + WS_BAR); for (int i = blockIdx.x * 512 + threadIdx.x; i < 4096; i += G * 512) bw[i] = 0u; }
    grid.sync();
    const XcdBarrier xb = xcd_barrier_post((unsigned*)(ws + WS_BAR), xst);
    prologue(fresh_args(), lds);
    xcd_barrier(xb);
    { pg8::Gemm g{H, WT_IN, T, N_IN_PAD, 2048, 2048}; pg8::StaticOrder S; S.init(T, N_IN_PAD, G, cidx);
      EpiIn E{CQKV, DQKV, GATES, KR, SSQ_Q, SSQ_KV, fresh_args()->b_gate, RC, RS, CTL};
      pg8::gemm_phase(lds, g, S, E);
      const int rem = (64 * (N_IN_PAD / 256)) % G; int tw_ = threadIdx.x; asm volatile("" : "+v"(tw_)); const int wv = __builtin_amdgcn_readfirstlane(tw_ >> 6);
      if (rem == 0) convert_weights(fresh_args(), lds, SEG_UQ, NSEG, cidx * 8 + wv, G * 8);
      else if (cidx >= rem) convert_weights(fresh_args(), lds, SEG_UQ, NSEG, (cidx - rem) * 8 + wv, (G - rem) * 8); }
    xcd_barrier(xb);
    { int tl_ = threadIdx.x; asm volatile("" : "+v"(tl_)); const int ln = tl_ & 63;
      KArgs ka = fresh_args(); const float* lq1 = ka->lq1; const float* lk1 = ka->lk1; const float* lq2 = ka->lq2; const float* lk2 = ka->lk2;
      float s1 = lq1[ln] * lk1[ln] + lq1[64 + ln] * lk1[64 + ln];
      float s2 = lq2[ln] * lk2[ln] + lq2[64 + ln] * lk2[64 + ln];
      const float lam = __expf(wave_sum(s1, ln)) - __expf(wave_sum(s2, ln)) + LAMBDA_INIT;
      att::Tensors Tn{DQKV, 6144, DQKV + 2048, 6144, DQKV + 4096, nullptr, YDIFF, ka->diff_norm_g, lam, CTL, CTL + 768};
      att::phase<true>(lds, Tn); }
    xcd_barrier(xb);
    { pg8::Gemm g{CQKV, WT_UQ, T, 3072, 768, 1280}; pg8::StaticOrder S; S.init(T, 3072, G, cidx);
      EpiUQ E{Qb, SSQ_Q, RC, RS, CTL};
      pg8::gemm_phase(lds, g, S, E); }
    { pg8::Gemm g{CQKV + 768, WT_UKV, T, 4096, 512, 1280}; pg8::StaticOrder S; S.init(T, 4096, G, cidx);
      EpiUKV E{KVb, SSQ_KV, CTL};
      pg8::gemm_phase(lds, g, S, E); }
    xcd_barrier(xb);
    { att::Tensors Tn{Qb, 3072, KVb, 4096, KVb + 128, KR, YMLA, nullptr, 0.f, CTL, nullptr};
      att::phase<false>(lds, Tn); }
    xcd_barrier(xb);
    { pg8::Gemm g{YMLA, WT_MLA, T, 2048, 2048, 2048}; pg8::StaticOrder S; S.init(T, 2048, G, cidx);
      EpiMixA E{MERGED, GATES};
      pg8::gemm_phase(lds, g, S, E); }
    { pg8::Gemm g{YDIFF, WT_DIFF, T, 2048, 2048, 2048}; pg8::StaticOrder S; S.init(T, 2048, G, cidx);
      EpiMixB E{GATES, MERGED};
      pg8::gemm_phase(lds, g, S, E); }
    xcd_barrier(xb);
    { pg8::Gemm g{MERGED, WT_OUT, T, 2048, 2048, 2048}; pg8::StaticOrder S; S.init(T, 2048, G, cidx);
      EpiRes<true> E{fresh_args()->x, outp, X1B, SSQ_F};
      pg8::gemm_phase(lds, g, S, E); }
    xcd_barrier(xb);
    { pg8::Gemm g{X1B, WT_GU, T, 2 * D_FF, 2048, 2048}; pg8::StaticOrder S; S.init(T, 2 * D_FF, G, cidx);
      EpiGU E{Ub, SSQ_F};
      pg8::gemm_phase(lds, g, S, E); }
    xcd_barrier(xb);
    { pg8::Gemm g{Ub, WT_DN, T, 2048, D_FF, D_FF}; pg8::StaticOrder S; S.init(T, 2048, G, cidx);
      EpiRes<false> E{outp, outp, nullptr, nullptr};
      pg8::gemm_phase(lds, g, S, E); }
    xcd_barrier(xb);
    { const float* fng = fresh_args()->final_norm_g; int tf_ = threadIdx.x; asm volatile("" : "+v"(tf_)); const int lane = tf_ & 63, wave = tf_ >> 6, gw = blockIdx.x * 8 + wave, NGW = G * 8;
      for (int row = gw; row < T; row += 2 * NGW) {
          const int row1 = row + NGW; const bool two = row1 < T;
          f32x4* xr0 = (f32x4*)(outp + (size_t)row * DM) + lane; f32x4* xr1 = (f32x4*)(outp + (size_t)(two ? row1 : row) * DM) + lane;
          f32x4 v0[8], v1[8]; float s0 = 0.f, s1 = 0.f;
#pragma unroll
          for (int j = 0; j < 8; ++j) v0[j] = xr0[64 * j];
#pragma unroll
          for (int j = 0; j < 8; ++j) v1[j] = xr1[64 * j];
#pragma unroll
          for (int j = 0; j < 8; ++j) { s0 += dot4(v0[j]); s1 += dot4(v1[j]); }
          const float rs0 = __builtin_amdgcn_rsqf(wave_sum(s0, lane) * (1.0f / DM) + EPS), rs1 = __builtin_amdgcn_rsqf(wave_sum(s1, lane) * (1.0f / DM) + EPS);
#pragma unroll
          for (int j = 0; j < 8; ++j) { const f32x4 g = *((const f32x4*)fng + lane + 64 * j); xr0[64 * j] = v0[j] * rs0 * g; if (two) xr1[64 * j] = v1[j] * rs1 * g; } } }
}

extern "C" void kernel_launch(void* const* d_in, const int* in_sizes, int n_in, void* d_out, int out_size, void* d_ws, size_t ws_size, hipStream_t stream) {
    static int grid = 0;
    if (grid == 0) {
        if (n_in != 21 || in_sizes[0] != T * DM || out_size != T * DM || ws_size < WS_END) {
            fprintf(stderr, "kernel_launch: unexpected shapes (n_in %d, in0 %d, out %d, ws %zu, need %zu)\n", n_in, n_in > 0 ? in_sizes[0] : -1, out_size, ws_size, (size_t)WS_END); grid = -1; return; }
        int dev = 0, cus = 0, per_cu = 0;
        if (hipGetDevice(&dev) != hipSuccess || hipDeviceGetAttribute(&cus, hipDeviceAttributeMultiprocessorCount, dev) != hipSuccess) { grid = -1; return; }
        if (hipFuncSetAttribute((const void*)fwd_kernel, hipFuncAttributeMaxDynamicSharedMemorySize, LDS_BYTES) != hipSuccess) { fprintf(stderr, "kernel_launch: hipFuncSetAttribute failed\n"); grid = -1; return; }
        if (hipOccupancyMaxActiveBlocksPerMultiprocessor(&per_cu, (const void*)fwd_kernel, 512, LDS_BYTES) != hipSuccess || per_cu < 1) { fprintf(stderr, "kernel_launch: occupancy query gave %d\n", per_cu); per_cu = 1; }
        (void)hipGetLastError();
        grid = cus * per_cu;
    }
    if (grid < 0) return;
    Args a{};
    const float** ap = (const float**)&a;
    for (int i = 0; i < 21; ++i) ap[i] = (const float*)d_in[i];
    a.out = (float*)d_out; a.ws = (unsigned char*)d_ws;
    void* args[] = {&a};
    hipError_t e = hipLaunchCooperativeKernel((const void*)fwd_kernel, dim3(grid), dim3(512), args, LDS_BYTES, stream);
    if (e != hipSuccess) fprintf(stderr, "cooperative launch failed: %s (grid %d)\n", hipGetErrorString(e), grid);
}
```

```cpp
#include <hip/hip_runtime.h>
#include <hip/hip_cooperative_groups.h>
#include <cstdio>
#include <cstdint>
namespace cg = cooperative_groups;

#define LAS __attribute__((address_space(3)))
#define DI __device__ __forceinline__
typedef unsigned short bf16_t;
typedef short bf16x8 __attribute__((ext_vector_type(8)));
typedef short s16x4 __attribute__((ext_vector_type(4)));
typedef float f32x4 __attribute__((ext_vector_type(4)));
typedef float f32x16 __attribute__((ext_vector_type(16)));
typedef unsigned u32x4 __attribute__((ext_vector_type(4)));
typedef unsigned u32x2 __attribute__((ext_vector_type(2)));
typedef float f32x2_t __attribute__((ext_vector_type(2)));
typedef __bf16 bf16x2_t __attribute__((ext_vector_type(2)));

constexpr int SEQ = 8192, BATCH = 2, T = BATCH * SEQ, DM = 2048;
constexpr int D_IN = 11584, D_FF = 5632;
constexpr int N_IN_PAD = 11776;
constexpr float EPS = 1e-6f;
constexpr float LOG2E = 1.4426950408889634f;
constexpr float QSCALE_MLA = 0.10411754627697264f;
constexpr float QSCALE_DIFF = 0.12751743082459868f;
constexpr float LAMBDA_INIT = 0.2f;

constexpr size_t SZ_WT_IN = (size_t)N_IN_PAD * 2048 * 2, SZ_WT_UQ = (size_t)3072 * 768 * 2, SZ_WT_UKV = (size_t)4096 * 512 * 2, SZ_WT_SQ = (size_t)2048 * 2048 * 2,
                 SZ_WT_GU = (size_t)2 * D_FF * 2048 * 2, SZ_WT_DN = (size_t)2048 * D_FF * 2;
constexpr size_t WS_WT_IN = 0, WS_WT_UQ = WS_WT_IN + SZ_WT_IN, WS_WT_UKV = WS_WT_UQ + SZ_WT_UQ, WS_WT_MLA = WS_WT_UKV + SZ_WT_UKV, WS_WT_DIFF = WS_WT_MLA + SZ_WT_SQ,
                 WS_WT_OUT = WS_WT_DIFF + SZ_WT_SQ, WS_WT_GU = WS_WT_OUT + SZ_WT_SQ, WS_WT_DN = WS_WT_GU + SZ_WT_GU, WS_ROPE_C = WS_WT_DN + SZ_WT_DN,
                 WS_ROPE_S = WS_ROPE_C + (size_t)SEQ * 32 * 4, WS_SSQ = WS_ROPE_S + (size_t)SEQ * 32 * 4, WS_CTL = WS_SSQ + (size_t)3 * T * 4, WS_BAR = WS_CTL + 4096, WS_KR = WS_BAR + 16384, WS_H = WS_KR + (size_t)T * 64 * 2,
                 WS_R1 = WS_H + (size_t)T * 2048 * 2, WS_R2 = WS_R1 + (size_t)T * (3072 + 4096) * 2, WS_END = WS_R2 + (size_t)T * 2048 * 2;
static_assert(WS_END <= (size_t)512 * 1024 * 1024, "workspace map exceeds 512 MiB");
static_assert(WS_WT_UQ % 256 == 0 && WS_ROPE_C % 256 == 0 && WS_KR % 256 == 0 && WS_H % 256 == 0 && WS_R1 % 256 == 0 && WS_R2 % 256 == 0, "alignment");

constexpr int LDS_BYTES = 147456;

struct Args {
    const float* x; const float* attn_norm_g; const float* w_in; const float* b_gate; const float* q_norm_g; const float* w_uq; const float* kv_norm_g; const float* w_ukv;
    const float* lq1; const float* lk1; const float* lq2; const float* lk2; const float* diff_norm_g; const float* w_mla_proj; const float* w_diff_proj; const float* w_out;
    const float* ffn_norm_g; const float* w_ffn_gate; const float* w_ffn_up; const float* w_ffn_down; const float* final_norm_g;
    float* out; unsigned char* ws;
};

DI unsigned cvtpk(float lo, float hi) { f32x2_t v = {lo, hi}; bf16x2_t b = __builtin_convertvector(v, bf16x2_t); return __builtin_bit_cast(unsigned, b); }
DI float bf_lo(unsigned u) { return __builtin_bit_cast(float, u << 16); }
DI float bf_hi(unsigned u) { return __builtin_bit_cast(float, u & 0xffff0000u); }
template <int MASK> DI float shx(float v, int lane) { return __builtin_bit_cast(float, __builtin_amdgcn_ds_bpermute((lane ^ MASK) << 2, __builtin_bit_cast(int, v))); }
DI float wave_sum(float v, int lane) {
    v += shx<1>(v, lane); v += shx<2>(v, lane); v += shx<4>(v, lane); v += shx<8>(v, lane); v += shx<16>(v, lane); v += shx<32>(v, lane);
    return v;
}
DI float fast_exp2(float x) { return __builtin_amdgcn_exp2f(x); }
DI float fast_rcp(float x) { return __builtin_amdgcn_rcpf(x); }
DI float sigmoidf_(float v) { return fast_rcp(1.0f + fast_exp2(-v * LOG2E)); }
DI void atomic_addf(float* p, float v) { (void)__hip_atomic_fetch_add(p, v, __ATOMIC_RELAXED, __HIP_MEMORY_SCOPE_AGENT); }

namespace pg8 {
constexpr int BM = 256, BK = 64, HALF = 128, HTB = HALF * BK * 2, STAGE_BYTES = 8 * HTB, NXCD = 8, WGM = 4;
DI int lds_byte(int r, int c) { const int st = (r >> 4) * 2 + (c >> 5), rr = r & 15, cc = c & 31, ob = rr * 64 + cc * 2; return st * 1024 + (ob ^ (((ob >> 9) & 1) << 5)); }
DI void stage_rc(int b, int& R, int& C) { const int st = b / 1024, sb = b % 1024, swz = sb ^ (((sb >> 9) & 1) << 5); R = (st >> 1) * 16 + swz / 64; C = (st & 1) * 32 + (swz % 64) / 2; }
DI int perm32(int rho) { const int n = rho >> 4, i = rho & 15; return 8 * (i >> 2) + 4 * n + (i & 3); }

struct Unit { int pm, pn; };
struct Gemm { const bf16_t* A; const bf16_t* Bt; int M, N, K, lda; };

struct StaticOrder {
    int nM, nN, nwg, G, c;
    DI void init(int M, int N, int G_, int c_) { nM = M / BM; nN = N / BM; nwg = nM * nN; G = G_; c = c_; }
    DI bool next(int i, Unit& u) const {
        const long L = (long)i * G + c; if (L >= nwg) return false;
        int wgid = (int)L; { const int q = nwg / NXCD, r = nwg % NXCD, xcd = wgid % NXCD, off = wgid / NXCD; wgid = (xcd < r ? xcd * (q + 1) : r * (q + 1) + (xcd - r) * q) + off; }
        const int nig = WGM * nN, gid = wgid / nig, fm = gid * WGM, gsz = (nM - fm) < WGM ? (nM - fm) : WGM;
        u.pm = fm + ((wgid % nig) % gsz); u.pn = (wgid % nig) / gsz; return true;
    }
    DI void a_ready(const Unit&) const {}
    DI void done(const Unit&) const {}
};

template <class Epi, class Sched>
DI void gemm_phase(LAS unsigned char* lds, const Gemm g, const Sched& S, const Epi& E) {
    int tid_ = threadIdx.x; asm volatile("" : "+v"(tid_));
    const int tid = tid_, wid = __builtin_amdgcn_readfirstlane(tid >> 6), lane = tid & 63, wr = wid >> 2, wc = wid & 3, fr = lane & 15, fq = lane >> 4;
    const int K = g.K, nt = K / BK, lda = g.lda;
    unsigned voffA[2], voffB[2];
#pragma unroll
    for (int i = 0; i < 2; ++i) { int R, C; stage_rc(tid * 16 + i * 8192, R, C); const int Rb = (R & ~31) + perm32(R & 31);
        voffA[i] = (unsigned)(R * lda + C) * 2u; voffB[i] = (unsigned)(Rb * K + C) * 2u; }
    const size_t kstep = (size_t)(BK * 2);
    const size_t hstepA = (size_t)HALF * lda * 2, hstepB = (size_t)HALF * K * 2;
    const size_t tstepA = 2 * hstepA, tstepB = 2 * hstepB;
    const unsigned ldsw = (unsigned)wid * 1024u;
    const int aoff = lds_byte(wr * 64 + fr, fq * 8), boff = lds_byte(wc * 32 + fr, fq * 8);
#define PG8_SA(b, h) (((b) * 2 + (h)) * HTB)
#define PG8_SB(b, h) ((4 + (b) * 2 + (h)) * HTB)
#define PG8_STAGE(bufoff, gbase, voff) do { _Pragma("unroll") for (int _i = 0; _i < 2; ++_i) \
        __builtin_amdgcn_global_load_lds((const unsigned*)((const char*)(gbase) + (voff)[_i]), (LAS unsigned*)(lds + (bufoff) + ldsw + _i * 8192), 16, 0, 0); } while (0)
#define PG8_LDA(dst, b, h) do { _Pragma("unroll") for (int m = 0; m < 4; ++m) _Pragma("unroll") for (int k = 0; k < 2; ++k) dst[m][k] = *(const LAS bf16x8*)(lds + PG8_SA(b, h) + aoff + m * 2048 + k * 1024); } while (0)
#define PG8_LDB(dst, b, h) do { _Pragma("unroll") for (int n = 0; n < 2; ++n) _Pragma("unroll") for (int k = 0; k < 2; ++k) dst[n][k] = *(const LAS bf16x8*)(lds + PG8_SB(b, h) + boff + n * 2048 + k * 1024); } while (0)
#define PG8_MMA(ai, bj, At, Bt) do { __builtin_amdgcn_s_setprio(1); _Pragma("unroll") for (int m = 0; m < 4; ++m) _Pragma("unroll") for (int n = 0; n < 2; ++n) _Pragma("unroll") for (int k = 0; k < 2; ++k) \
        acc[ai][bj][m][n] = __builtin_amdgcn_mfma_f32_16x16x32_bf16(Bt[n][k], At[m][k], acc[ai][bj][m][n], 0, 0, 0); __builtin_amdgcn_s_setprio(0); } while (0)
#define PG8_WAIT_V(n) asm volatile("s_waitcnt vmcnt(" #n ")" ::: "memory")
#define PG8_WAIT_L(n) asm volatile("s_waitcnt lgkmcnt(" #n ")" ::: "memory")
#define PG8_BAR __builtin_amdgcn_s_barrier()
#define PG8_SCHED __builtin_amdgcn_sched_barrier(0)
    Unit cur, nxt; int ui = 0;
    if (!S.next(0, cur)) return;
    f32x4 acc[2][2][4][2];
#pragma unroll
    for (int a = 0; a < 2; ++a)
#pragma unroll
        for (int b = 0; b < 2; ++b)
#pragma unroll
            for (int m = 0; m < 4; ++m)
#pragma unroll
                for (int n = 0; n < 2; ++n) acc[a][b][m][n] = (f32x4){0.f, 0.f, 0.f, 0.f};
    bf16x8 At[4][2], B0[2][2], B1[2][2];
    const char* cA = (const char*)g.A + (size_t)cur.pm * tstepA; const char* cB = (const char*)g.Bt + (size_t)cur.pn * tstepB;
    PG8_STAGE(PG8_SB(0, 0), cB, voffB); PG8_STAGE(PG8_SB(0, 1), cB + hstepB, voffB); PG8_STAGE(PG8_SA(0, 0), cA, voffA); PG8_STAGE(PG8_SA(0, 1), cA + hstepA, voffA);
    if (wr == 1) PG8_BAR;
    PG8_WAIT_V(2); PG8_BAR;
    PG8_STAGE(PG8_SB(1, 0), cB + kstep, voffB); PG8_STAGE(PG8_SA(1, 0), cA + kstep, voffA); PG8_STAGE(PG8_SB(1, 1), cB + hstepB + kstep, voffB);
    PG8_WAIT_V(6); PG8_BAR;
    for (;;) {
        const bool has_next = S.next(ui + 1, nxt);
        const char* nA = has_next ? (const char*)g.A + (size_t)nxt.pm * tstepA : cA; const char* nB = has_next ? (const char*)g.Bt + (size_t)nxt.pn * tstepB : cB;
        for (int t = 0; t < nt; t += 2) {
            const bool last = (t == nt - 2);
            const char* a1 = cA + (size_t)(t + 1) * kstep;
            const char* a2 = last ? nA : cA + (size_t)(t + 2) * kstep; const char* b2 = last ? nB : cB + (size_t)(t + 2) * kstep;
            const char* a3 = a2 + kstep; const char* b3 = b2 + kstep;
            PG8_LDB(B0, 0, 0); PG8_LDB(B1, 0, 1); PG8_SCHED; PG8_LDA(At, 0, 0); PG8_STAGE(PG8_SA(1, 1), a1 + hstepA, voffA);
            PG8_WAIT_V(8); PG8_WAIT_L(0); PG8_BAR; PG8_MMA(0, 0, At, B0); PG8_MMA(0, 1, At, B1); PG8_BAR; PG8_SCHED;
            PG8_LDA(At, 0, 1); PG8_STAGE(PG8_SB(0, 0), b2, voffB); PG8_STAGE(PG8_SB(0, 1), b2 + hstepB, voffB); PG8_STAGE(PG8_SA(0, 0), a2, voffA);
            PG8_WAIT_V(8); PG8_WAIT_L(0); PG8_BAR; PG8_MMA(1, 0, At, B0); PG8_MMA(1, 1, At, B1); PG8_BAR; PG8_SCHED;
            PG8_LDB(B0, 1, 0); PG8_LDB(B1, 1, 1); PG8_SCHED; PG8_LDA(At, 1, 0); PG8_STAGE(PG8_SA(0, 1), a2 + hstepA, voffA);
            PG8_WAIT_V(8); PG8_WAIT_L(0); PG8_BAR; PG8_MMA(0, 0, At, B0); PG8_MMA(0, 1, At, B1); PG8_BAR; PG8_SCHED;
            PG8_LDA(At, 1, 1); PG8_STAGE(PG8_SB(1, 0), b3, voffB); PG8_STAGE(PG8_SB(1, 1), b3 + hstepB, voffB); PG8_STAGE(PG8_SA(1, 0), a3, voffA);
            PG8_WAIT_V(8); PG8_WAIT_L(0); PG8_BAR; PG8_MMA(1, 0, At, B0); PG8_MMA(1, 1, At, B1); PG8_BAR; PG8_SCHED;
        }
        if (wr == 0) PG8_BAR;
        E(acc, cur, wr, wc, fr, fq);
        if (!has_next) break;
#pragma unroll
        for (int a = 0; a < 2; ++a)
#pragma unroll
            for (int b = 0; b < 2; ++b)
#pragma unroll
                for (int m = 0; m < 4; ++m)
#pragma unroll
                    for (int n = 0; n < 2; ++n) acc[a][b][m][n] = (f32x4){0.f, 0.f, 0.f, 0.f};
        cur = nxt; cA = nA; cB = nB; ++ui;
        if (wr == 1) PG8_BAR;
    }
    PG8_WAIT_V(0);
    PG8_BAR;
#undef PG8_SA
#undef PG8_SB
#undef PG8_STAGE
#undef PG8_LDA
#undef PG8_LDB
#undef PG8_MMA
#undef PG8_WAIT_V
#undef PG8_WAIT_L
#undef PG8_BAR
#undef PG8_SCHED
}
}

using pg8::Unit;
typedef const f32x4 (&AccRef)[2][2][4][2];

DI void store8_bf16(bf16_t* p, f32x4 v0, f32x4 v1) {
    u32x4 w; w.x = cvtpk(v0[0], v0[1]); w.y = cvtpk(v0[2], v0[3]); w.z = cvtpk(v1[0], v1[1]); w.w = cvtpk(v1[2], v1[3]);
    *(u32x4*)p = w;
}
DI void load8_bf16(const bf16_t* p, f32x4& v0, f32x4& v1) {
    const u32x4 w = *(const u32x4*)p;
    v0 = (f32x4){bf_lo(w.x), bf_hi(w.x), bf_lo(w.y), bf_hi(w.y)}; v1 = (f32x4){bf_lo(w.z), bf_hi(w.z), bf_lo(w.w), bf_hi(w.w)};
}
DI float dot4(f32x4 v) { return (v[0] * v[0] + v[1] * v[1]) + (v[2] * v[2] + v[3] * v[3]); }

#define EPI_HDR static constexpr bool PERM = true, AFTER_DRAIN = false;
DI void wave16_atomic_max(unsigned* p, float mv, int fr, int fq) {
    const int ln = fr | (fq << 4);
    mv = __builtin_fmaxf(mv, shx<1>(mv, ln)); mv = __builtin_fmaxf(mv, shx<2>(mv, ln)); mv = __builtin_fmaxf(mv, shx<4>(mv, ln)); mv = __builtin_fmaxf(mv, shx<8>(mv, ln));
    if (fr == 0 && fq == 0) (void)__hip_atomic_fetch_max(p, __builtin_bit_cast(unsigned, mv), __ATOMIC_RELAXED, __HIP_MEMORY_SCOPE_AGENT);
}
constexpr int CW_QCTR = 256, CW_NQ = 320, CW_NK = 512, CW_NKR = 704;
#define FOR_ROWS _Pragma("unroll") for (int ai = 0; ai < 2; ++ai) _Pragma("unroll") for (int m = 0; m < 4; ++m)
#define FOR_BJ _Pragma("unroll") for (int bj = 0; bj < 2; ++bj)

struct EpiIn { EPI_HDR
    bf16_t* cqkv; bf16_t* dqkv; bf16_t* gates; bf16_t* kr; float* ssq_q; float* ssq_kv; const float* b_gate; const float* rcos; const float* rsin; unsigned* nrm;
    DI void operator()(AccRef acc, const Unit& u, int wr, int wc, int fr, int fq) const {
        const int pn = u.pn, row0 = u.pm * 256 + wr * 64 + fr, c8 = wc * 32 + 8 * fq;
        if (pn < 5) {
            float* ssq = pn < 3 ? ssq_q : ssq_kv;
            FOR_ROWS { const int row = row0 + ai * 128 + m * 16; float s = 0.f;
                FOR_BJ { const f32x4 v0 = acc[ai][bj][m][0], v1 = acc[ai][bj][m][1]; s += dot4(v0) + dot4(v1);
                    store8_bf16(cqkv + (size_t)row * 1280 + pn * 256 + bj * 128 + c8, v0, v1); }
                s += shx<16>(s, fr | (fq << 4)); s += shx<32>(s, fr | (fq << 4));
                if (fq == 0) atomic_addf(ssq + row, s); }
        } else if (pn < 21) {
            const float sc = pn < 13 ? QSCALE_DIFF : 1.0f;
            float mxp[2] = {0.f, 0.f};
            FOR_ROWS { const int row = row0 + ai * 128 + m * 16;
                FOR_BJ { const f32x4 v0 = acc[ai][bj][m][0] * sc, v1 = acc[ai][bj][m][1] * sc; float s = dot4(v0) + dot4(v1);
                    s += shx<16>(s, fr | (fq << 4)); s += shx<32>(s, fr | (fq << 4)); mxp[bj] = __builtin_fmaxf(mxp[bj], s);
                    store8_bf16(dqkv + (size_t)row * 6144 + (pn - 5) * 256 + bj * 128 + c8, v0, v1); } }
            const int sel = (pn - 5) >> 3, head = (pn - 5) & 7, bb = u.pm >> 5;
            FOR_BJ { float mv = mxp[bj]; mv = __builtin_fmaxf(mv, shx<1>(mv, fr | (fq << 4))); mv = __builtin_fmaxf(mv, shx<2>(mv, fr | (fq << 4))); mv = __builtin_fmaxf(mv, shx<4>(mv, fr | (fq << 4))); mv = __builtin_fmaxf(mv, shx<8>(mv, fr | (fq << 4)));
                if (fr == 0 && fq == 0) (void)__hip_atomic_fetch_max(nrm + ((((bb * 8 + head) * 2 + bj) * 2 + sel) * 4 + wc), __builtin_bit_cast(unsigned, mv), __ATOMIC_RELAXED, __HIP_MEMORY_SCOPE_AGENT); }
        } else if (pn < 29) {
            FOR_ROWS { const int row = row0 + ai * 128 + m * 16;
                FOR_BJ store8_bf16(dqkv + (size_t)row * 6144 + (pn - 5) * 256 + bj * 128 + c8, acc[ai][bj][m][0], acc[ai][bj][m][1]); }
        } else if (pn < 45) {
            f32x4 b0[2], b1[2];
            FOR_BJ { const float* bp = b_gate + (pn - 29) * 256 + bj * 128 + c8; b0[bj] = *(const f32x4*)bp; b1[bj] = *(const f32x4*)(bp + 4); }
            FOR_ROWS { const int row = row0 + ai * 128 + m * 16;
                FOR_BJ { f32x4 v0 = acc[ai][bj][m][0] + b0[bj], v1 = acc[ai][bj][m][1] + b1[bj];
#pragma unroll
                    for (int e = 0; e < 4; ++e) { v0[e] = sigmoidf_(v0[e]); v1[e] = sigmoidf_(v1[e]); }
                    store8_bf16(gates + (size_t)row * 4096 + (pn - 29) * 256 + bj * 128 + c8, v0, v1); } }
        } else {
            if (wc == 0) {
                float mxr = 0.f;
                FOR_ROWS { const int row = row0 + ai * 128 + m * 16, pos = row & (SEQ - 1);
                    f32x4 o1[2], o2[2]; float sq = 0.f;
#pragma unroll
                    for (int n = 0; n < 2; ++n) { const f32x4 c = *(const f32x4*)(rcos + pos * 32 + 8 * fq + 4 * n), s = *(const f32x4*)(rsin + pos * 32 + 8 * fq + 4 * n);
                        const f32x4 x1 = acc[ai][0][m][n], x2 = acc[ai][1][m][n]; o1[n] = x1 * c - x2 * s; o2[n] = x2 * c + x1 * s; sq += dot4(o1[n]) + dot4(o2[n]); }
                    sq += shx<16>(sq, fr | (fq << 4)); sq += shx<32>(sq, fr | (fq << 4)); mxr = __builtin_fmaxf(mxr, sq);
                    store8_bf16(kr + (size_t)row * 64 + 8 * fq, o1[0], o1[1]); store8_bf16(kr + (size_t)row * 64 + 32 + 8 * fq, o2[0], o2[1]); }
                wave16_atomic_max(nrm + CW_NKR + (u.pm >> 5), mxr, fr, fq);
            }
        }
    }
};
struct EpiUQ { EPI_HDR
    bf16_t* Q; const float* ssq_q; const float* rcos; const float* rsin; unsigned* ctl;
    DI void operator()(AccRef acc, const Unit& u, int wr, int wc, int fr, int fq) const {
        const int pn = u.pn, row0 = u.pm * 256 + wr * 64 + fr, c8 = wc * 32 + 8 * fq;
        float mxp[2] = {0.f, 0.f};
        FOR_ROWS { const int row = row0 + ai * 128 + m * 16; const float rs = __builtin_amdgcn_rsqf(ssq_q[row] * (1.0f / 768.0f) + EPS) * QSCALE_MLA;
            if (pn < 8) {
                FOR_BJ { const f32x4 v0 = acc[ai][bj][m][0] * rs, v1 = acc[ai][bj][m][1] * rs; float sq = dot4(v0) + dot4(v1);
                    sq += shx<16>(sq, fr | (fq << 4)); sq += shx<32>(sq, fr | (fq << 4)); mxp[bj] = __builtin_fmaxf(mxp[bj], sq);
                    store8_bf16(Q + (size_t)row * 3072 + (2 * pn + bj) * 192 + c8, v0, v1); }
            } else {
                const int head = 4 * (pn - 8) + wc, pos = row & (SEQ - 1);
                f32x4 o1[2], o2[2]; float sq = 0.f;
#pragma unroll
                for (int n = 0; n < 2; ++n) { const f32x4 c = *(const f32x4*)(rcos + pos * 32 + 8 * fq + 4 * n), s = *(const f32x4*)(rsin + pos * 32 + 8 * fq + 4 * n);
                    const f32x4 x1 = acc[ai][0][m][n] * rs, x2 = acc[ai][1][m][n] * rs; o1[n] = x1 * c - x2 * s; o2[n] = x2 * c + x1 * s; sq += dot4(o1[n]) + dot4(o2[n]); }
                sq += shx<16>(sq, fr | (fq << 4)); sq += shx<32>(sq, fr | (fq << 4)); mxp[0] = __builtin_fmaxf(mxp[0], sq);
                store8_bf16(Q + (size_t)row * 3072 + head * 192 + 128 + 8 * fq, o1[0], o1[1]); store8_bf16(Q + (size_t)row * 3072 + head * 192 + 160 + 8 * fq, o2[0], o2[1]);
            } }
        const int bb = u.pm >> 5;
        if (pn < 8) { FOR_BJ wave16_atomic_max(ctl + CW_NQ + ((bb * 16 + 2 * pn + bj) * 5 + wc), mxp[bj], fr, fq); }
        else wave16_atomic_max(ctl + CW_NQ + ((bb * 16 + 4 * (pn - 8) + wc) * 5 + 4), mxp[0], fr, fq);
    }
};
struct EpiUKV { EPI_HDR
    bf16_t* KV; const float* ssq_kv; unsigned* ctl;
    DI void operator()(AccRef acc, const Unit& u, int wr, int wc, int fr, int fq) const {
        const int row0 = u.pm * 256 + wr * 64 + fr, c8 = wc * 32 + 8 * fq;
        float mxk = 0.f;
        FOR_ROWS { const int row = row0 + ai * 128 + m * 16; const float rs = __builtin_amdgcn_rsqf(ssq_kv[row] * (1.0f / 512.0f) + EPS);
            FOR_BJ { const f32x4 v0 = acc[ai][bj][m][0] * rs, v1 = acc[ai][bj][m][1] * rs;
                if (bj == 0) { float sq = dot4(v0) + dot4(v1); sq += shx<16>(sq, fr | (fq << 4)); sq += shx<32>(sq, fr | (fq << 4)); mxk = __builtin_fmaxf(mxk, sq); }
                store8_bf16(KV + (size_t)row * 4096 + u.pn * 256 + bj * 128 + c8, v0, v1); } }
        wave16_atomic_max(ctl + CW_NK + (((u.pm >> 5) * 16 + u.pn) * 4 + wc), mxk, fr, fq);
    }
};
struct EpiMixA { EPI_HDR
    bf16_t* merged; const bf16_t* gates;
    DI void operator()(AccRef acc, const Unit& u, int wr, int wc, int fr, int fq) const {
        const int row0 = u.pm * 256 + wr * 64 + fr, c8 = wc * 32 + 8 * fq;
        FOR_ROWS { const int row = row0 + ai * 128 + m * 16;
            FOR_BJ { const int col = u.pn * 256 + bj * 128 + c8; f32x4 g0, g1; load8_bf16(gates + (size_t)row * 4096 + col, g0, g1);
                store8_bf16(merged + (size_t)row * 2048 + col, acc[ai][bj][m][0] * g0, acc[ai][bj][m][1] * g1); } }
    }
};
struct EpiMixB { EPI_HDR
    const bf16_t* gates; bf16_t* merged;
    DI void operator()(AccRef acc, const Unit& u, int wr, int wc, int fr, int fq) const {
        const int row0 = u.pm * 256 + wr * 64 + fr, c8 = wc * 32 + 8 * fq;
        FOR_ROWS { const int row = row0 + ai * 128 + m * 16;
            FOR_BJ { const int col = u.pn * 256 + bj * 128 + c8; f32x4 g0, g1; load8_bf16(gates + (size_t)row * 4096 + 2048 + col, g0, g1);
                f32x4 t0, t1; load8_bf16(merged + (size_t)row * 2048 + col, t0, t1);
                store8_bf16(merged + (size_t)row * 2048 + col, t0 + acc[ai][bj][m][0] * g0, t1 + acc[ai][bj][m][1] * g1); } }
    }
};
template <bool WITH_B> struct EpiRes { EPI_HDR
    const float* base; float* out; bf16_t* outb; float* ssq;
    DI void operator()(AccRef acc, const Unit& u, int wr, int wc, int fr, int fq) const {
        const int row0 = u.pm * 256 + wr * 64 + fr, c8 = wc * 32 + 8 * fq;
        FOR_ROWS { const int row = row0 + ai * 128 + m * 16; float s = 0.f;
            FOR_BJ { const size_t off = (size_t)row * 2048 + u.pn * 256 + bj * 128 + c8;
                const f32x4 v0 = *(const f32x4*)(base + off) + acc[ai][bj][m][0], v1 = *(const f32x4*)(base + off + 4) + acc[ai][bj][m][1];
                *(f32x4*)(out + off) = v0; *(f32x4*)(out + off + 4) = v1;
                if (WITH_B) { store8_bf16(outb + off, v0, v1); s += dot4(v0) + dot4(v1); } }
            if (WITH_B) { s += shx<16>(s, fr | (fq << 4)); s += shx<32>(s, fr | (fq << 4)); if (fq == 0) atomic_addf(ssq + row, s); } }
    }
};
struct EpiGU { EPI_HDR
    bf16_t* U; const float* ssq;
    DI void operator()(AccRef acc, const Unit& u, int wr, int wc, int fr, int fq) const {
        const int row0 = u.pm * 256 + wr * 64 + fr, c8 = wc * 32 + 8 * fq;
        FOR_ROWS { const int row = row0 + ai * 128 + m * 16; const float rs = __builtin_amdgcn_rsqf(ssq[row] * (1.0f / 2048.0f) + EPS);
            f32x4 o[2];
#pragma unroll
            for (int n = 0; n < 2; ++n) { const f32x4 gv = acc[ai][0][m][n] * rs, uv = acc[ai][1][m][n] * rs;
#pragma unroll
                for (int e = 0; e < 4; ++e) o[n][e] = gv[e] * sigmoidf_(gv[e]) * uv[e]; }
            store8_bf16(U + (size_t)row * D_FF + u.pn * 128 + c8, o[0], o[1]); }
    }
};

namespace att {
template <bool DIFF> struct Cfg;
template <> struct Cfg<false> { static constexpr int NKS = 12, NDT = 4, KSTR = 400, VSTR = 320, NST = 5; };
template <> struct Cfg<true>  { static constexpr int NKS = 8,  NDT = 8, KSTR = 528, VSTR = 576, NST = 8; };
DI f32x16 mfma32(bf16x8 a, bf16x8 b, f32x16 c) { return __builtin_amdgcn_mfma_f32_32x32x16_bf16(a, b, c, 0, 0, 0); }
DI s16x4 vtr(const LAS unsigned char* p) { return __builtin_bit_cast(s16x4, __builtin_amdgcn_ds_read_tr16_b64_v4i16((LAS s16x4*)p)); }
DI bf16x8 pack8(const f32x16& x, int s) {
    u32x4 p; p.x = cvtpk(x[8 * s + 0], x[8 * s + 1]); p.y = cvtpk(x[8 * s + 2], x[8 * s + 3]); p.z = cvtpk(x[8 * s + 4], x[8 * s + 5]); p.w = cvtpk(x[8 * s + 6], x[8 * s + 7]);
    return __builtin_bit_cast(bf16x8, p);
}

struct Tensors {
    const bf16_t* Q;   int q_pitch;
    const bf16_t* K;   int k_pitch;
    const bf16_t* V;
    const bf16_t* KR;
    bf16_t* Y;
    const float* sub_g; float lam;
    const unsigned* nrm; unsigned* qctr;
};

template <bool DIFF, bool NOMAX>
DI void unit(LAS unsigned char* lds, const Tensors& Tn, int b, int hd, int qb) {
    typedef Cfg<DIFF> C;
    constexpr int NKS = C::NKS, NDT = C::NDT, KSTR = C::KSTR, VSTR = C::VSTR, NST = C::NST;
    constexpr int K_BYTES = 64 * KSTR, V_BYTES = 64 * VSTR, STAGE = K_BYTES + V_BYTES;
    int tid_ = threadIdx.x; asm volatile("" : "+v"(tid_));
    const int tid = tid_, w = __builtin_amdgcn_readfirstlane(tid >> 6), lane = tid & 63, r = lane & 31, h = lane >> 5;
    const int wq = DIFF ? (w & 3) : w, map = DIFF ? (w >> 2) : 0;
    const int q0 = DIFF ? qb * 128 + 32 * wq : qb * 256 + 32 * wq;
    const int need = (q0 >> 6) + 1;
    const int ntiles = DIFF ? 2 * qb + 2 : 4 * qb + 4;
    int jst = 0, jbeg = 0;
    const float sl2 = DIFF ? __builtin_amdgcn_exp2f(-(float)(hd + 1)) * LOG2E : 0.f;
    if (DIFF) {
        float wd[2];
#pragma unroll
        for (int mp = 0; mp < 2; ++mp) { const unsigned* nq = Tn.nrm + (((b * 8 + hd) * 2 + mp) * 2 + 0) * 4; const unsigned* nk = nq + 4;
            const float sq = (__builtin_bit_cast(float, nq[0]) + __builtin_bit_cast(float, nq[1])) + (__builtin_bit_cast(float, nq[2]) + __builtin_bit_cast(float, nq[3]));
            const float sk = (__builtin_bit_cast(float, nk[0]) + __builtin_bit_cast(float, nk[1])) + (__builtin_bit_cast(float, nk[2]) + __builtin_bit_cast(float, nk[3]));
            const float B2 = __builtin_sqrtf(sq * sk) * 1.02f;
            wd[mp] = (152.0f + 2.0f * B2) / sl2; }
        const float lim = (float)(q0 - 63) - wd[map], limb = (float)(qb * 128 - 63) - __builtin_fmaxf(wd[0], wd[1]);
        jst = lim > 0.f ? (int)__builtin_ceilf(lim * (1.0f / 64.0f)) : 0; jbeg = limb > 0.f ? (int)__builtin_ceilf(limb * (1.0f / 64.0f)) : 0;
        jst = __builtin_amdgcn_readfirstlane(jst); jbeg = __builtin_amdgcn_readfirstlane(jbeg);
        if (jst < jbeg) jst = jbeg;
    }
    const size_t tok0 = (size_t)b * SEQ;

    if (w >= 4) __builtin_amdgcn_s_setprio(1);
    bf16x8 qf[NKS];
    {
        const bf16_t* qp = Tn.Q + (tok0 + q0 + r) * Tn.q_pitch + (DIFF ? hd * 256 + map * 128 : hd * 192) + 8 * h;
#pragma unroll
        for (int ks = 0; ks < NKS; ++ks) qf[ks] = *(const bf16x8*)(qp + 16 * ks);
    }
    constexpr int NP = STAGE / 1024, NPW = (NP + 7) / 8, KCH = DIFF ? 32 : 24, VCH = DIFF ? 32 : 16;
    unsigned goff[NPW];
#pragma unroll
    for (int i = 0; i < NPW; ++i) {
        const int ob = (w + 8 * i) * 1024 + lane * 16; unsigned off;
        if (ob < K_BYTES) { const int row = ob / KSTR, ch = (ob % KSTR) / 16;
            if (DIFF) off = (ch < KCH) ? (unsigned)((row * 6144 + 2048 + hd * 256 + ch * 8) * 2) : 0u;
            else off = (ch < 16) ? (unsigned)((row * 4096 + hd * 256 + ch * 8) * 2) : (ch < KCH ? (0x80000000u | (unsigned)((row * 64 + (ch - 16) * 8) * 2)) : 0u);
        } else { const int o2 = ob - K_BYTES, row = o2 / VSTR, ch = (o2 % VSTR) / 16;
            if (DIFF) off = (ch < VCH && row < 64) ? (unsigned)((row * 6144 + 4096 + hd * 256 + ch * 8) * 2) : 0u;
            else off = (ch < VCH && row < 64) ? (unsigned)((row * 4096 + hd * 256 + 128 + ch * 8) * 2) : 0u;
        }
        goff[i] = off;
    }
    const char* kvbase = (const char*)(DIFF ? Tn.Q : Tn.K) + tok0 * (DIFF ? 6144 : 4096) * 2;
    const char* krbase = DIFF ? kvbase : (const char*)Tn.KR + tok0 * 64 * 2;
#define ATT_ISSUE(j, buf) do { const char* kvb = kvbase + (size_t)(j) * 64 * (DIFF ? 6144 : 4096) * 2; const char* krb = krbase + (size_t)(j) * 64 * 64 * 2; \
        _Pragma("unroll") for (int i = 0; i < NPW; ++i) { if (w + 8 * i < NP) { \
            const char* src = (!DIFF && (goff[i] & 0x80000000u)) ? krb + (goff[i] & 0x7fffffffu) : kvb + goff[i]; \
            __builtin_amdgcn_global_load_lds((const unsigned*)src, (LAS unsigned*)(lds + (buf) * STAGE + (w + 8 * i) * 1024), 16, 0, 0); } } } while (0)

    f32x16 o[NDT];
#pragma unroll
    for (int dt = 0; dt < NDT; ++dt)
#pragma unroll
        for (int e = 0; e < 16; ++e) o[dt][e] = 0.f;
    float mrow = 0.f, lrow = 0.f;
    const int i16 = lane & 15, tq = i16 >> 2, tp = i16 & 3, g16 = (lane >> 4) & 1;
    const unsigned koff = r * KSTR + h * 16 + (DIFF ? map * 256 : 0);
    const unsigned voff = K_BYTES + (4 * h + tq) * VSTR + (16 * g16 + 4 * tp) * 2;

    constexpr int NSTG = DIFF ? 2 : 3;
    const bool full_w = (w + 8 * (NPW - 1) < NP);
    int sb = 0;
    ATT_ISSUE(jbeg, 0);
    if (NSTG == 3 && jbeg + 1 < ntiles) ATT_ISSUE(jbeg + 1, 1);
    if (NSTG == 3 && jbeg + 1 < ntiles) { if (full_w) asm volatile("s_waitcnt vmcnt(%0)" :: "n"(NPW) : "memory"); else asm volatile("s_waitcnt vmcnt(%0)" :: "n"(NPW - 1) : "memory"); }
    else asm volatile("s_waitcnt vmcnt(0)" ::: "memory");
    __builtin_amdgcn_s_barrier();
    for (int j = jbeg; j < ntiles; ++j) {
        const int sbn = (sb + NSTG - 1 >= NSTG) ? sb - 1 : sb + NSTG - 1;
        if (j + NSTG - 1 < ntiles) ATT_ISSUE(j + NSTG - 1, sbn);
        if (j >= jst && j < need) {
            const LAS unsigned char* kb = lds + sb * STAGE + koff;
            const unsigned vba = (unsigned)(uintptr_t)(lds + sb * STAGE + voff);
            constexpr int DK = DIFF ? (NOMAX ? 4 : 2) : 6, DV = DIFF ? (NOMAX ? 2 : 1) : 6, NPV = 2 * NDT;
            bf16x8 kf[DK]; s16x4 vlo[DV], vhi[DV];
#define SGB(mask, n) __builtin_amdgcn_sched_group_barrier(mask, n, 0)
#define LDK(hf_, ks_) (*(const LAS bf16x8*)(kb + (hf_) * 32 * KSTR + (ks_) * 32))
#define VTR(dst_, off_) asm volatile("ds_read_b64_tr_b16 %0, %1 offset:%c2" : "=v"(dst_) : "v"(vba), "i"(off_) : "memory")
#define LDV(i_, hf_) do { VTR(vlo[(i_) % DV], (16 * (2 * (hf_) + ((i_) & 1))) * VSTR + 64 * ((i_) >> 1)); VTR(vhi[(i_) % DV], (16 * (2 * (hf_) + ((i_) & 1)) + 8) * VSTR + 64 * ((i_) >> 1)); } while (0)
#define VWAIT(n_, a_, b_) asm volatile("s_waitcnt lgkmcnt(%c2)" : "+v"(a_), "+v"(b_) : "i"(n_) : "memory")
#pragma unroll
            for (int i = 0; i < DK; ++i) kf[i] = LDK(0, i);
            SGB(0x100, DK);
#pragma unroll
            for (int hf = 0; hf < 2; ++hf) {
                const bool offd = DIFF && (j < need - 1);
                f32x16 sc;
                if (offd) {
                    const float A = sl2 * (float)(64 * j + 32 * hf + 4 * h - q0) - (NOMAX ? 0.f : mrow);
                    float tg[4] = {A, __builtin_fmaf(sl2, 8.f, A), __builtin_fmaf(sl2, 16.f, A), __builtin_fmaf(sl2, 24.f, A)};
#pragma unroll
                    for (int g = 0; g < 4; ++g) asm volatile("" : "+v"(tg[g]));
#pragma unroll
                    for (int e = 0; e < 16; ++e) sc[e] = __builtin_fmaf(sl2, (float)(e & 3), tg[e >> 2]);
                } else {
                    const float base = (DIFF ? sl2 * (float)r : 0.f) - (NOMAX ? 0.f : mrow);
#pragma unroll
                    for (int e = 0; e < 16; ++e) sc[e] = base;
                }
#pragma unroll
                for (int ks = 0; ks < NKS; ++ks) {
                    sc = mfma32(kf[ks % DK], qf[ks], sc);
                    if (ks + DK < NKS) kf[ks % DK] = LDK(hf, ks + DK);
                }
#pragma unroll
                for (int ks = 0; ks < NKS; ++ks) { SGB(0x8, 1); if (ks + DK < NKS) SGB(0x100, 1); }
                __builtin_amdgcn_sched_barrier(0);
#pragma unroll
                for (int i = 0; i < DV; ++i) LDV(i, hf);
                if (DIFF && !offd) {
                    const float qk = (float)(q0 + r - 64 * j - 4 * h - 32 * hf);
                    float tq[4] = {qk, qk - 8.f, qk - 16.f, qk - 24.f};
#pragma unroll
                    for (int g = 0; g < 4; ++g) asm volatile("" : "+v"(tq[g]));
#pragma unroll
                    for (int e = 0; e < 16; ++e) sc[e] = __builtin_fmaf(-sl2, __builtin_fabsf(tq[e >> 2] - (float)(e & 3)), sc[e]);
                }
                float mx = sc[0];
                if (!NOMAX) {
#pragma unroll
                for (int e = 1; e < 16; ++e) mx = __builtin_fmaxf(mx, sc[e]);
                { auto rr = __builtin_amdgcn_permlane32_swap(__builtin_bit_cast(unsigned, mx), __builtin_bit_cast(unsigned, mx), false, false);
                  mx = __builtin_fmaxf(__builtin_bit_cast(float, rr[0]), __builtin_bit_cast(float, rr[1])); }
                }
                const bool first = (j == jst) && (hf == 0);
                if (!NOMAX && (first || __any(mx > 8.0f))) {
                    const float mn = first ? mx : __builtin_fmaxf(mx, 0.f), al = first ? 1.0f : fast_exp2(-mn);
#pragma unroll
                    for (int dt = 0; dt < NDT; ++dt) o[dt] = o[dt] * al;
                    lrow *= al; mrow += mn;
#pragma unroll
                    for (int e = 0; e < 16; ++e) sc[e] -= mn;
                }
                f32x2_t ps2 = {0.f, 0.f};
#pragma unroll
                for (int e = 0; e < 16; e += 2) { sc[e] = fast_exp2(sc[e]); sc[e + 1] = fast_exp2(sc[e + 1]); ps2 += (f32x2_t){sc[e], sc[e + 1]}; }
                lrow += ps2.x + ps2.y;
                bf16x8 pb[2]; pb[0] = pack8(sc, 0); pb[1] = pack8(sc, 1);
#pragma unroll
                for (int i = 0; i < NPV; ++i) {
                    VWAIT(2 * ((NPV - 1 - i) < (DV - 1) ? (NPV - 1 - i) : (DV - 1)), vlo[i % DV], vhi[i % DV]);
                    const bf16x8 vf = __builtin_shufflevector(vlo[i % DV], vhi[i % DV], 0, 1, 2, 3, 4, 5, 6, 7);
                    o[i >> 1] = mfma32(vf, pb[i & 1], o[i >> 1]);
                    if (i + DV < NPV) LDV(i + DV, hf);
                }
                __builtin_amdgcn_sched_barrier(0);
                if (hf == 0) {
#pragma unroll
                    for (int i = 0; i < DK; ++i) kf[i] = LDK(1, i);
                    SGB(0x100, DK);
                }
            }
#undef SGB
#undef LDK
#undef VTR
#undef LDV
#undef VWAIT
        }
        if (NSTG == 3 && j + 2 < ntiles) { if (full_w) asm volatile("s_waitcnt vmcnt(%0) lgkmcnt(0)" :: "n"(NPW) : "memory"); else asm volatile("s_waitcnt vmcnt(%0) lgkmcnt(0)" :: "n"(NPW - 1) : "memory"); }
        else asm volatile("s_waitcnt vmcnt(0) lgkmcnt(0)" ::: "memory");
        __builtin_amdgcn_s_barrier();
        sb = (sb + 1 == NSTG) ? 0 : sb + 1;
    }
#undef ATT_ISSUE
    __builtin_amdgcn_s_setprio(0);
    int tid2_ = threadIdx.x; asm volatile("" : "+v"(tid2_));
    const int lane2 = tid2_ & 63, w2 = __builtin_amdgcn_readfirstlane(tid2_ >> 6), wq2 = DIFF ? (w2 & 3) : w2, map2 = DIFF ? (w2 >> 2) : 0;
    const int r2 = lane2 & 31, h2 = lane2 >> 5, q02 = DIFF ? qb * 128 + 32 * wq2 : qb * 256 + 32 * wq2;
    const float ltot = lrow + shx<32>(lrow, lane2);
    const float inv = 1.0f / ltot;
    if (!DIFF) {
        bf16_t* yp = Tn.Y + (tok0 + q02 + r2) * 2048 + hd * 128 + 4 * h2;
#pragma unroll
        for (int dt = 0; dt < NDT; ++dt)
#pragma unroll
            for (int g = 0; g < 4; ++g) { u32x2 pk; pk.x = cvtpk(o[dt][4 * g] * inv, o[dt][4 * g + 1] * inv); pk.y = cvtpk(o[dt][4 * g + 2] * inv, o[dt][4 * g + 3] * inv);
                *(u32x2*)(yp + 32 * dt + 8 * g) = pk; }
    } else {
        LAS float* X = (LAS float*)lds;
        if (map2 == 1) {
#pragma unroll
            for (int dt = 0; dt < NDT; ++dt)
#pragma unroll
                for (int e = 0; e < 16; ++e) X[(wq2 * 128 + dt * 16 + e) * 64 + lane2] = o[dt][e] * inv;
        }
        __syncthreads();
        if (map2 == 0) {
            float ss = 0.f;
#pragma unroll
            for (int dt = 0; dt < NDT; ++dt)
#pragma unroll
                for (int e = 0; e < 16; ++e) { const float v = o[dt][e] * inv - Tn.lam * X[(wq2 * 128 + dt * 16 + e) * 64 + lane2]; o[dt][e] = v; ss += v * v; }
            ss += shx<32>(ss, lane2);
            const float rs = __builtin_amdgcn_rsqf(ss * (1.0f / 256.0f) + EPS) * (1.0f - LAMBDA_INIT);
            bf16_t* yp = Tn.Y + (tok0 + q02 + r2) * 2048 + hd * 256 + 4 * h2;
#pragma unroll
            for (int dt = 0; dt < NDT; ++dt)
#pragma unroll
                for (int g = 0; g < 4; ++g) { const f32x4 gg = *(const f32x4*)(Tn.sub_g + 32 * dt + 8 * g + 4 * h2);
                    u32x2 pk; pk.x = cvtpk(o[dt][4 * g] * rs * gg[0], o[dt][4 * g + 1] * rs * gg[1]); pk.y = cvtpk(o[dt][4 * g + 2] * rs * gg[2], o[dt][4 * g + 3] * rs * gg[3]);
                    *(u32x2*)(yp + 32 * dt + 8 * g) = pk; }
        }
        __syncthreads();
    }
}

template <bool DIFF>
DI float score_bound(const Tensors& Tn, int b, int hd) {
    float bound;
    if (DIFF) {
        bound = 0.f;
#pragma unroll
        for (int mp = 0; mp < 2; ++mp) { const unsigned* nq = Tn.nrm + (((b * 8 + hd) * 2 + mp) * 2 + 0) * 4; const unsigned* nk = nq + 4;
            const float sq = (__builtin_bit_cast(float, nq[0]) + __builtin_bit_cast(float, nq[1])) + (__builtin_bit_cast(float, nq[2]) + __builtin_bit_cast(float, nq[3]));
            const float sk = (__builtin_bit_cast(float, nk[0]) + __builtin_bit_cast(float, nk[1])) + (__builtin_bit_cast(float, nk[2]) + __builtin_bit_cast(float, nk[3]));
            bound = __builtin_fmaxf(bound, __builtin_sqrtf(sq * sk) * 1.02f); }
    } else {
        const unsigned* nq = Tn.nrm + CW_NQ + (b * 16 + hd) * 5; const unsigned* nk = Tn.nrm + CW_NK + (b * 16 + hd) * 4;
        const float sq = (__builtin_bit_cast(float, nq[0]) + __builtin_bit_cast(float, nq[1])) + (__builtin_bit_cast(float, nq[2]) + __builtin_bit_cast(float, nq[3])) + __builtin_bit_cast(float, nq[4]);
        const float sk = (__builtin_bit_cast(float, nk[0]) + __builtin_bit_cast(float, nk[1])) + (__builtin_bit_cast(float, nk[2]) + __builtin_bit_cast(float, nk[3])) + __builtin_bit_cast(float, Tn.nrm[CW_NKR + b]);
        bound = __builtin_sqrtf(sq * sk) * 1.02f;
    }
    return __builtin_bit_cast(float, __builtin_amdgcn_readfirstlane(__builtin_bit_cast(int, bound)));
}

template <bool DIFF>
DI void phase(LAS unsigned char* lds, const Tensors& Tn) {
    constexpr int NQ = DIFF ? 64 : 32, NBH = DIFF ? 16 : 32, HALFQ = NQ / 2, NPAIR = NBH * HALFQ;
    const int G = gridDim.x, c = blockIdx.x;
    if (DIFF) {
        LAS unsigned* slot = (LAS unsigned*)(lds + LDS_BYTES - 64);
        if (threadIdx.x == 0) slot[1] = 0u;
        __syncthreads();
        for (;;) {
            const unsigned qi = slot[1];
            if (qi >= 8u) break;
            const int q = (int)((blockIdx.x + qi) & 7u);
            if (threadIdx.x == 0) slot[0] = __hip_atomic_fetch_add(Tn.qctr + 16 * q, 1u, __ATOMIC_RELAXED, __HIP_MEMORY_SCOPE_AGENT);
            __syncthreads();
            const unsigned uu = slot[0];
            __syncthreads();
            if (uu >= 128u) { if (threadIdx.x == 0) slot[1] = qi + 1u; __syncthreads(); continue; }
            const int bq = q >> 2, hq = (uu & 1u) ? 7 - (q & 3) : (q & 3), qbx = 63 - (int)(uu >> 1);
            if (score_bound<DIFF>(Tn, bq, hq) < 75.0f) unit<DIFF, true>(lds, Tn, bq, hq, qbx); else unit<DIFF, false>(lds, Tn, bq, hq, qbx);
        }
        return;
    }
    for (int p = c; p < NPAIR; p += G) {
        int bh, a;
        if (G == 256) { const int xcd = c & 7, idx = (c >> 3) + 32 * (p / 256); bh = xcd * (NBH / 8) + idx / HALFQ; a = idx % HALFQ; }
        else { bh = p / HALFQ; a = p % HALFQ; }
        const int b = bh / (NBH / 2), hd = bh % (NBH / 2);
        if (score_bound<DIFF>(Tn, b, hd) < 100.0f) { unit<DIFF, true>(lds, Tn, b, hd, NQ - 1 - a); unit<DIFF, true>(lds, Tn, b, hd, a); }
        else { unit<DIFF, false>(lds, Tn, b, hd, NQ - 1 - a); unit<DIFF, false>(lds, Tn, b, hd, a); }
    }
}
}

struct TrItem { const float* W; int srcN, src, K; bf16_t* WT; int dst_row, k0; const float* gain; };
DI void tr_load(const TrItem& t, f32x4 (&v)[8], int lane) {
    if (t.src < 0) return;
    const float* wp = t.W + (size_t)(t.k0 + (lane >> 3)) * t.srcN + t.src + (lane & 7) * 4;
#pragma unroll
    for (int i = 0; i < 8; ++i) v[i] = *(const f32x4*)(wp + (size_t)(8 * i) * t.srcN);
}
DI void tr_store(const TrItem& t, const f32x4 (&v)[8], LAS float* scr, int lane) {
    const int c = lane & 7, K = t.K;
    if (t.src < 0) {
#pragma unroll
        for (int j = 0; j < 4; ++j) { const int n = (lane >> 3) + 8 * j; *(u32x4*)(t.WT + (size_t)(t.dst_row + n) * K + t.k0 + 8 * c) = (u32x4){0u, 0u, 0u, 0u}; }
        return;
    }
    { const int kk = lane >> 3, c4 = (lane & 7) * 4;
#pragma unroll
      for (int i = 0; i < 8; ++i) { const float gn = t.gain ? t.gain[t.k0 + 8 * i + kk] : 1.0f; LAS float* sp = scr + (8 * i + kk) * 33 + c4;
          sp[0] = v[i][0] * gn; sp[1] = v[i][1] * gn; sp[2] = v[i][2] * gn; sp[3] = v[i][3] * gn; } }
    asm volatile("s_waitcnt lgkmcnt(0)" ::: "memory");
#pragma unroll
    for (int j = 0; j < 4; ++j) { const int n = (lane >> 3) + 8 * j; const LAS float* sp = scr + (8 * c) * 33 + n;
        u32x4 o; o.x = cvtpk(sp[0 * 33], sp[1 * 33]); o.y = cvtpk(sp[2 * 33], sp[3 * 33]); o.z = cvtpk(sp[4 * 33], sp[5 * 33]); o.w = cvtpk(sp[6 * 33], sp[7 * 33]);
        *(u32x4*)(t.WT + (size_t)(t.dst_row + n) * K + t.k0 + 8 * c) = o; }
    asm volatile("s_waitcnt lgkmcnt(0)" ::: "memory");
}

typedef const __attribute__((address_space(4))) Args* KArgs;
DI KArgs fresh_args() { KArgs p = (KArgs)__builtin_amdgcn_kernarg_segment_ptr(); asm volatile("" : "+s"(p)); return p; }
enum { SEG_IN = 0, SEG_UQ, SEG_UKV, SEG_MLA, SEG_DIFF, SEG_OUT, SEG_GU, SEG_DN, NSEG };

DI void convert_weights(KArgs a, LAS unsigned char* lds, int seg_lo, int seg_hi, int gw, int NGW);
DI void prologue(KArgs a, LAS unsigned char* lds) {
    unsigned char* ws = a->ws;
    int tid_ = threadIdx.x; asm volatile("" : "+v"(tid_));
    const int tid = tid_, lane = tid & 63, wave = __builtin_amdgcn_readfirstlane(tid >> 6);
    const int G = gridDim.x, gw = blockIdx.x * 8 + wave, NGW = G * 8, gt = blockIdx.x * 512 + tid, NGT = G * 512;
    { float* ssq = (float*)(ws + WS_SSQ); for (int i = gt; i < 3 * T + 1024; i += NGT) ssq[i] = 0.f; }
    { float* rc = (float*)(ws + WS_ROPE_C); float* rsn = (float*)(ws + WS_ROPE_S);
      for (int i = gt; i < SEQ * 32; i += NGT) { const int pos = i >> 5, f = i & 31;
          const float inv = (float)exp2(-(double)f * 0.4152410118609203);
          const float ang = (float)pos * inv;
          const double t = (double)ang * 0.15915494309189535;
          const float fr = (float)(t - rint(t));
          rc[i] = __builtin_amdgcn_cosf(fr); rsn[i] = __builtin_amdgcn_sinf(fr); } }
    { bf16_t* H = (bf16_t*)(ws + WS_H);
      for (int row = gw; row < T; row += 2 * NGW) {
          const int row1 = row + NGW; const bool two = row1 < T;
          const f32x4* xr0 = (const f32x4*)(a->x + (size_t)row * DM) + lane; const f32x4* xr1 = (const f32x4*)(a->x + (size_t)(two ? row1 : row) * DM) + lane;
          f32x4 v0[8], v1[8]; float s0 = 0.f, s1 = 0.f;
#pragma unroll
          for (int j = 0; j < 8; ++j) v0[j] = xr0[64 * j];
#pragma unroll
          for (int j = 0; j < 8; ++j) v1[j] = xr1[64 * j];
#pragma unroll
          for (int j = 0; j < 8; ++j) { s0 += dot4(v0[j]); s1 += dot4(v1[j]); }
          const float rs0 = __builtin_amdgcn_rsqf(wave_sum(s0, lane) * (1.0f / DM) + EPS), rs1 = __builtin_amdgcn_rsqf(wave_sum(s1, lane) * (1.0f / DM) + EPS);
          u32x2* o0 = (u32x2*)(H + (size_t)row * DM) + lane; u32x2* o1 = (u32x2*)(H + (size_t)row1 * DM) + lane;
#pragma unroll
          for (int j = 0; j < 8; ++j) { const f32x4 g = *((const f32x4*)a->attn_norm_g + lane + 64 * j); const f32x4 y0 = v0[j] * rs0 * g, y1 = v1[j] * rs1 * g;
              u32x2 pk; pk.x = cvtpk(y0[0], y0[1]); pk.y = cvtpk(y0[2], y0[3]); o0[64 * j] = pk;
              if (two) { u32x2 pk1; pk1.x = cvtpk(y1[0], y1[1]); pk1.y = cvtpk(y1[2], y1[3]); o1[64 * j] = pk1; } } } }
    convert_weights(a, lds, SEG_IN, SEG_IN + 1, gw, NGW);
}

DI void convert_weights(KArgs a, LAS unsigned char* lds, int seg_lo, int seg_hi, int gw, int NGW) {
    unsigned char* ws = a->ws;
    int tid_ = threadIdx.x; asm volatile("" : "+v"(tid_));
    const int lane = tid_ & 63, wave = __builtin_amdgcn_readfirstlane(tid_ >> 6);
    LAS float* scr = (LAS float*)(lds + wave * 16384);
    int base = 0;
#pragma unroll 1
    for (int seg = seg_lo; seg < seg_hi; ++seg) {
        int K, ngr;
        switch (seg) { case SEG_IN: K = 2048; ngr = N_IN_PAD / 32; break; case SEG_UQ: K = 768; ngr = 96; break; case SEG_UKV: K = 512; ngr = 128; break;
                       case SEG_GU: K = 2048; ngr = 352; break; case SEG_DN: K = D_FF; ngr = 64; break; default: K = 2048; ngr = 64; break; }
        const int nkb = K / 64, nitems = ngr * nkb;
        const int first = (int)(((long)gw - base % NGW + NGW) % NGW);
#define DECODE_ITEM(it_, T_) do { const int g = (it_) % ngr, k0 = ((it_) / ngr) * 64; \
            const float* W; int srcN, src; bf16_t* WT; const float* gain = nullptr; \
            switch (seg) { \
            case SEG_IN: { W = a->w_in; srcN = D_IN; WT = (bf16_t*)(ws + WS_WT_IN); const int n0 = g * 32; \
            if (n0 < 1280) src = n0; else if (n0 < 7424) src = n0 + 64; else if (n0 < 11520) src = n0 + 64; \
            else { const int j = n0 - 11520; src = (j == 0) ? 1280 : (j == 128 ? 1312 : -1); } } break; \
            case SEG_UQ: { W = a->w_uq; srcN = 3072; WT = (bf16_t*)(ws + WS_WT_UQ); gain = a->q_norm_g; \
            if (g < 64) src = (g >> 2) * 192 + (g & 3) * 32; \
            else { const int gp = g - 64, t = gp >> 3, j = gp & 7; src = (4 * t + (j & 3)) * 192 + 128 + (j >> 2) * 32; } } break; \
            case SEG_UKV: W = a->w_ukv; srcN = 4096; WT = (bf16_t*)(ws + WS_WT_UKV); gain = a->kv_norm_g; src = g * 32; break; \
            case SEG_MLA: W = a->w_mla_proj; srcN = 2048; WT = (bf16_t*)(ws + WS_WT_MLA); src = g * 32; break; \
            case SEG_DIFF: W = a->w_diff_proj; srcN = 2048; WT = (bf16_t*)(ws + WS_WT_DIFF); src = g * 32; break; \
            case SEG_OUT: W = a->w_out; srcN = 2048; WT = (bf16_t*)(ws + WS_WT_OUT); src = g * 32; break; \
            case SEG_GU: { const int t = g >> 3, j = g & 7; W = (j < 4) ? a->w_ffn_gate : a->w_ffn_up; srcN = D_FF; WT = (bf16_t*)(ws + WS_WT_GU); gain = a->ffn_norm_g; src = 128 * t + 32 * (j & 3); } break; \
            default: W = a->w_ffn_down; srcN = 2048; WT = (bf16_t*)(ws + WS_WT_DN); src = g * 32; break; \
            } \
            T_.W = W; T_.srcN = srcN; T_.src = src; T_.K = K; T_.WT = WT; T_.dst_row = g * 32; T_.k0 = k0; T_.gain = gain; } while (0)
#pragma unroll 1
        for (int it = first; it < nitems; it += 2 * NGW) {
            TrItem t0, t1; f32x4 v0[8], v1[8]; const bool two = (it + NGW < nitems);
            DECODE_ITEM(it, t0); tr_load(t0, v0, lane);
            if (two) { DECODE_ITEM(it + NGW, t1); tr_load(t1, v1, lane); }
            tr_store(t0, v0, scr, lane);
            if (two) tr_store(t1, v1, scr, lane);
        }
#undef DECODE_ITEM
        base += nitems;
    }
}


#define XB_TMO      128
#define XB_XCNT(j)  (256  + 64 * (j))
#define XB_XSUB(j)  (1280 + 64 * (j))
#define XB_XGEN(j)  (2304 + 64 * (j))
#define XB_TOP      3328
#define XB_TOPGEN   3392
#define XCD_BAR_WORDS 3456
#define XB_SPIN_CAP (1u << 18)
DI unsigned xb_ld(unsigned* p)              { return __hip_atomic_load(p, __ATOMIC_RELAXED, __HIP_MEMORY_SCOPE_AGENT); }
DI unsigned xb_add(unsigned* p, unsigned v) { return __hip_atomic_fetch_add(p, v, __ATOMIC_RELAXED, __HIP_MEMORY_SCOPE_AGENT); }
DI unsigned xb_xcc_id() { return (unsigned)__builtin_amdgcn_s_getreg((3 << 11) | 20) & 0xFu; }
#define XB_SPIN(cond, bar) do { unsigned _sp = 0; while (cond) { __builtin_amdgcn_s_sleep(1); \
    if ((++_sp & 255u) == 0u) { if (xb_ld(&(bar)[XB_TMO])) break; if (_sp > XB_SPIN_CAP) { atomicAdd(&(bar)[XB_TMO], 1u); break; } } } } while (0)
struct XcdBarrier { unsigned* bar; unsigned x; volatile LAS unsigned* st; };
DI XcdBarrier xcd_barrier_post(unsigned* bar, volatile LAS unsigned* st) {
    XcdBarrier b; b.bar = bar; b.x = xb_xcc_id(); b.st = st;
    if (threadIdx.x == 0) (void)xb_add(&bar[XB_XCNT(b.x)], 1u);
    return b;
}
DI void xcd_barrier_complete(unsigned* bar, unsigned x, unsigned& nloc, unsigned& nx) {
    const unsigned G = gridDim.x * gridDim.y * gridDim.z;
    unsigned sum, cnt, mine, sp = 0u;
    for (;;) {
        sum = 0u; cnt = 0u; mine = 0u;
#pragma unroll
        for (unsigned j = 0; j < 16; ++j) { const unsigned c = xb_ld(&bar[XB_XCNT(j)]); sum += c; cnt += (c > 0u) ? 1u : 0u; mine = (j == x) ? c : mine; }
        if (sum == G) break;
        __builtin_amdgcn_s_sleep(1);
        if ((++sp & 255u) == 0u) { if (xb_ld(&bar[XB_TMO])) break; if (sp > XB_SPIN_CAP) { atomicAdd(&bar[XB_TMO], 1u); break; } }
    }
    nloc = mine > 0u ? mine : 1u; nx = cnt > 0u ? cnt : 1u;
}
DI void xcd_barrier(const XcdBarrier& b) {
    asm volatile("s_waitcnt vmcnt(0)" ::: "memory");
    __syncthreads();
    if (threadIdx.x == 0) {
        unsigned* bar = b.bar;
        __builtin_amdgcn_s_waitcnt(0);
        unsigned nloc = b.st[0], nx = b.st[1];
        if (nloc == 0u) { xcd_barrier_complete(bar, b.x, nloc, nx); b.st[0] = nloc; b.st[1] = nx; }
        const unsigned old = xb_add(&bar[XB_XSUB(b.x)], 1u);
        const unsigned gen = old / nloc;
        if (old + 1u == (gen + 1u) * nloc) {
            __builtin_amdgcn_fence(__ATOMIC_RELEASE, "agent");
            asm volatile("s_waitcnt vmcnt(0)" ::: "memory");
            const unsigned og = xb_add(&bar[XB_TOP], 1u);
            const unsigned tg = og / nx;
            if (og + 1u == (tg + 1u) * nx) xb_add(&bar[XB_TOPGEN], 1u);
            else XB_SPIN(xb_ld(&bar[XB_TOPGEN]) == tg, bar);
            __builtin_amdgcn_fence(__ATOMIC_ACQUIRE, "agent");
            xb_add(&bar[XB_XGEN(b.x)], 1u);
            asm volatile("s_waitcnt vmcnt(0)" ::: "memory");
        } else {
            XB_SPIN(xb_ld(&bar[XB_XGEN(b.x)]) == gen, bar);
            __builtin_amdgcn_fence(__ATOMIC_ACQUIRE, "agent");
            asm volatile("s_waitcnt vmcnt(0)" ::: "memory");
        }
    }
    __syncthreads();
}

__global__ void __launch_bounds__(512, 2) fwd_kernel(Args a_unused) {
    extern __shared__ __attribute__((aligned(16))) unsigned char lds_raw[];
    LAS unsigned char* lds = (LAS unsigned char*)lds_raw;
    cg::grid_group grid = cg::this_grid();
    volatile LAS unsigned* xst = (volatile LAS unsigned*)(lds + LDS_BYTES - 32);
    if (threadIdx.x == 0) { xst[0] = 0u; xst[1] = 0u; }
    unsigned char* ws = fresh_args()->ws; float* const outp = fresh_args()->out;
    const int G = gridDim.x, cidx = blockIdx.x;
    bf16_t* WT_IN = (bf16_t*)(ws + WS_WT_IN); bf16_t* WT_UQ = (bf16_t*)(ws + WS_WT_UQ); bf16_t* WT_UKV = (bf16_t*)(ws + WS_WT_UKV); bf16_t* WT_MLA = (bf16_t*)(ws + WS_WT_MLA);
    bf16_t* WT_DIFF = (bf16_t*)(ws + WS_WT_DIFF); bf16_t* WT_OUT = (bf16_t*)(ws + WS_WT_OUT); bf16_t* WT_GU = (bf16_t*)(ws + WS_WT_GU); bf16_t* WT_DN = (bf16_t*)(ws + WS_WT_DN);
    float* RC = (float*)(ws + WS_ROPE_C); float* RS = (float*)(ws + WS_ROPE_S);
    float* SSQ_Q = (float*)(ws + WS_SSQ); float* SSQ_KV = SSQ_Q + T; float* SSQ_F = SSQ_KV + T;
    unsigned* CTL = (unsigned*)(ws + WS_CTL);
    bf16_t* KR = (bf16_t*)(ws + WS_KR); bf16_t* H = (bf16_t*)(ws + WS_H); bf16_t* YDIFF = H;
    bf16_t* DQKV = (bf16_t*)(ws + WS_R1); bf16_t* Qb = (bf16_t*)(ws + WS_R1); bf16_t* KVb = Qb + (size_t)T * 3072;
    bf16_t* MERGED = (bf16_t*)(ws + WS_R1 + (size_t)T * 2048 * 4); bf16_t* Ub = (bf16_t*)(ws + WS_R1);
    bf16_t* CQKV = (bf16_t*)(ws + WS_R2); bf16_t* YMLA = (bf16_t*)(ws + WS_R2); bf16_t* X1B = (bf16_t*)(ws + WS_R2);
    bf16_t* GATES = (bf16_t*)outp;

    { unsigned* bw = (unsigned*)(ws + WS_BAR); for (int i = blockIdx.x * 512 + threadIdx.x; i < 4096; i += G * 512) bw[i] = 0u; }
    grid.sync();
    const XcdBarrier xb = xcd_barrier_post((unsigned*)(ws + WS_BAR), xst);
    prologue(fresh_args(), lds);
    xcd_barrier(xb);
    { pg8::Gemm g{H, WT_IN, T, N_IN_PAD, 2048, 2048}; pg8::StaticOrder S; S.init(T, N_IN_PAD, G, cidx);
      EpiIn E{CQKV, DQKV, GATES, KR, SSQ_Q, SSQ_KV, fresh_args()->b_gate, RC, RS, CTL};
      pg8::gemm_phase(lds, g, S, E);
      const int rem = (64 * (N_IN_PAD / 256)) % G; int tw_ = threadIdx.x; asm volatile("" : "+v"(tw_)); const int wv = __builtin_amdgcn_readfirstlane(tw_ >> 6);
      if (rem == 0) convert_weights(fresh_args(), lds, SEG_UQ, NSEG, cidx * 8 + wv, G * 8);
      else if (cidx >= rem) convert_weights(fresh_args(), lds, SEG_UQ, NSEG, (cidx - rem) * 8 + wv, (G - rem) * 8); }
    xcd_barrier(xb);
    { int tl_ = threadIdx.x; asm volatile("" : "+v"(tl_)); const int ln = tl_ & 63;
      KArgs ka = fresh_args(); const float* lq1 = ka->lq1; const float* lk1 = ka->lk1; const float* lq2 = ka->lq2; const float* lk2 = ka->lk2;
      float s1 = lq1[ln] * lk1[ln] + lq1[64 + ln] * lk1[64 + ln];
      float s2 = lq2[ln] * lk2[ln] + lq2[64 + ln] * lk2[64 + ln];
      const float lam = __expf(wave_sum(s1, ln)) - __expf(wave_sum(s2, ln)) + LAMBDA_INIT;
      att::Tensors Tn{DQKV, 6144, DQKV + 2048, 6144, DQKV + 4096, nullptr, YDIFF, ka->diff_norm_g, lam, CTL, CTL + 768};
      att::phase<true>(lds, Tn); }
    xcd_barrier(xb);
    { pg8::Gemm g{CQKV, WT_UQ, T, 3072, 768, 1280}; pg8::StaticOrder S; S.init(T, 3072, G, cidx);
      EpiUQ E{Qb, SSQ_Q, RC, RS, CTL};
      pg8::gemm_phase(lds, g, S, E); }
    { pg8::Gemm g{CQKV + 768, WT_UKV, T, 4096, 512, 1280}; pg8::StaticOrder S; S.init(T, 4096, G, cidx);
      EpiUKV E{KVb, SSQ_KV, CTL};
      pg8::gemm_phase(lds, g, S, E); }
    xcd_barrier(xb);
    { att::Tensors Tn{Qb, 3072, KVb, 4096, KVb + 128, KR, YMLA, nullptr, 0.f, CTL, nullptr};
      att::phase<false>(lds, Tn); }
    xcd_barrier(xb);
    { pg8::Gemm g{YMLA, WT_MLA, T, 2048, 2048, 2048}; pg8::StaticOrder S; S.init(T, 2048, G, cidx);
      EpiMixA E{MERGED, GATES};
      pg8::gemm_phase(lds, g, S, E); }
    { pg8::Gemm g{YDIFF, WT_DIFF, T, 2048, 2048, 2048}; pg8::StaticOrder S; S.init(T, 2048, G, cidx);
      EpiMixB E{GATES, MERGED};
      pg8::gemm_phase(lds, g, S, E); }
    xcd_barrier(xb);
    { pg8::Gemm g{MERGED, WT_OUT, T, 2048, 2048, 2048}; pg8::StaticOrder S; S.init(T, 2048, G, cidx);
      EpiRes<true> E{fresh_args()->x, outp, X1B, SSQ_F};
      pg8::gemm_phase(lds, g, S, E); }
    xcd_barrier(xb);
    { pg8::Gemm g{X1B, WT_GU, T, 2 * D_FF, 2048, 2048}; pg8::StaticOrder S; S.init(T, 2 * D_FF, G, cidx);
      EpiGU E{Ub, SSQ_F};
      pg8::gemm_phase(lds, g, S, E); }
    xcd_barrier(xb);
    { pg8::Gemm g{Ub, WT_DN, T, 2048, D_FF, D_FF}; pg8::StaticOrder S; S.init(T, 2048, G, cidx);
      EpiRes<false> E{outp, outp, nullptr, nullptr};
      pg8::gemm_phase(lds, g, S, E); }
    xcd_barrier(xb);
    { const float* fng = fresh_args()->final_norm_g; int tf_ = threadIdx.x; asm volatile("" : "+v"(tf_)); const int lane = tf_ & 63, wave = tf_ >> 6, gw = blockIdx.x * 8 + wave, NGW = G * 8;
      for (int row = gw; row < T; row += 2 * NGW) {
          const int row1 = row + NGW; const bool two = row1 < T;
          f32x4* xr0 = (f32x4*)(outp + (size_t)row * DM) + lane; f32x4* xr1 = (f32x4*)(outp + (size_t)(two ? row1 : row) * DM) + lane;
          f32x4 v0[8], v1[8]; float s0 = 0.f, s1 = 0.f;
#pragma unroll
          for (int j = 0; j < 8; ++j) v0[j] = xr0[64 * j];
#pragma unroll
          for (int j = 0; j < 8; ++j) v1[j] = xr1[64 * j];
#pragma unroll
          for (int j = 0; j < 8; ++j) { s0 += dot4(v0[j]); s1 += dot4(v1[j]); }
          const float rs0 = __builtin_amdgcn_rsqf(wave_sum(s0, lane) * (1.0f / DM) + EPS), rs1 = __builtin_amdgcn_rsqf(wave_sum(s1, lane) * (1.0f / DM) + EPS);
#pragma unroll
          for (int j = 0; j < 8; ++j) { const f32x4 g = *((const f32x4*)fng + lane + 64 * j); xr0[64 * j] = v0[j] * rs0 * g; if (two) xr1[64 * j] = v1[j] * rs1 * g; } } }
}

extern "C" void kernel_launch(void* const* d_in, const int* in_sizes, int n_in, void* d_out, int out_size, void* d_ws, size_t ws_size, hipStream_t stream) {
    static int grid = 0;
    if (grid == 0) {
        if (n_in != 21 || in_sizes[0] != T * DM || out_size != T * DM || ws_size < WS_END) {
            fprintf(stderr, "kernel_launch: unexpected shapes (n_in %d, in0 %d, out %d, ws %zu, need %zu)\n", n_in, n_in > 0 ? in_sizes[0] : -1, out_size, ws_size, (size_t)WS_END); grid = -1; return; }
        int dev = 0, cus = 0, per_cu = 0;
        if (hipGetDevice(&dev) != hipSuccess || hipDeviceGetAttribute(&cus, hipDeviceAttributeMultiprocessorCount, dev) != hipSuccess) { grid = -1; return; }
        if (hipFuncSetAttribute((const void*)fwd_kernel, hipFuncAttributeMaxDynamicSharedMemorySize, LDS_BYTES) != hipSuccess) { fprintf(stderr, "kernel_launch: hipFuncSetAttribute failed\n"); grid = -1; return; }
        if (hipOccupancyMaxActiveBlocksPerMultiprocessor(&per_cu, (const void*)fwd_kernel, 512, LDS_BYTES) != hipSuccess || per_cu < 1) { fprintf(stderr, "kernel_launch: occupancy query gave %d\n", per_cu); per_cu = 1; }
        (void)hipGetLastError();
        grid = cus * per_cu;
    }
    if (grid < 0) return;
    Args a{};
    const float** ap = (const float**)&a;
    for (int i = 0; i < 21; ++i) ap[i] = (const float*)d_in[i];
    a.out = (float*)d_out; a.ws = (unsigned char*)d_ws;
    void* args[] = {&a};
    hipError_t e = hipLaunchCooperativeKernel((const void*)fwd_kernel, dim3(grid), dim3(512), args, LDS_BYTES, stream);
    if (e != hipSuccess) fprintf(stderr, "cooperative launch failed: %s (grid %d)\n", hipGetErrorString(e), grid);
}
```
